# Optimizing an MI355X kernel written in HIP

```python
import jax, jax.numpy as jnp
from jax import lax
import numpy as np

D_MODEL = 1024
BATCH = 2
SEQ = 8192
DEPTH = 1
DEC_BATCH = 16
DEC_SEQ = 16
PAST_LEN = 1024

CHUNK = 64
N_META = 16
H_A = 8
DH = 64
W_A = H_A * DH
N_CG = 8
W_C = D_MODEL - W_A
CONV_W = 3
Q_BLOCK = 128
SPLIT_SIZES = [W_A, W_A, W_A, W_A, H_A, W_C, W_C, W_C, W_C]
N_IN = sum(SPLIT_SIZES)
SPLIT_IDX = [int(i) for i in np.cumsum(SPLIT_SIZES)[:-1]]
EPS = 1e-6

kernel_name = "hymba_fox_shortconv_stream_step"


def rmsnorm(x, g):
    xf = x.astype(jnp.float32)
    y = xf * lax.rsqrt(jnp.mean(xf * xf, axis=-1, keepdims=True) + EPS)
    return (y * g.astype(jnp.float32)).astype(x.dtype)


def project(h, w_in, b_f):
    p = jnp.einsum('bld,dn->bln', h, w_in)
    q, k, v, za, fl, bg, cg, hc, zc = jnp.split(p, SPLIT_IDX, axis=-1)
    B, L = h.shape[:2]
    q = q.reshape(B, L, H_A, DH)
    k = k.reshape(B, L, H_A, DH)
    v = v.reshape(B, L, H_A, DH)
    logf = jax.nn.log_sigmoid((fl + b_f).astype(jnp.float32))
    u = cg * hc
    return q, k, v, za, logf, bg, u, zc


def fox_block(qblk, cq, qpos, k, v, ck, kpos):
    s = jnp.einsum('bqhd,bkhd->bhqk', qblk, k, preferred_element_type=jnp.float32) * (DH ** -0.5)
    s = s + jnp.transpose(cq, (0, 2, 1))[..., None] - jnp.transpose(ck, (0, 2, 1))[:, :, None, :]
    mask = kpos[None, :] <= qpos[:, None]
    s = jnp.where(mask[None, None], s, -jnp.inf)
    p = jax.nn.softmax(s, axis=-1)
    return jnp.einsum('bhqk,bkhd->bqhd', p.astype(v.dtype), v)


def fox_prompt_attention(q, k, v, logf):
    B, L = q.shape[:2]
    c = jnp.cumsum(logf, axis=1)
    nb = -(-L // Q_BLOCK)
    pad = nb * Q_BLOCK - L
    qb = jnp.pad(q, ((0, 0), (0, pad), (0, 0), (0, 0))).reshape(B, nb, Q_BLOCK, H_A, DH)
    qb = jnp.transpose(qb, (1, 0, 2, 3, 4))
    cb = jnp.pad(c, ((0, 0), (0, pad), (0, 0))).reshape(B, nb, Q_BLOCK, H_A)
    cb = jnp.transpose(cb, (1, 0, 2, 3))
    starts = jnp.arange(nb, dtype=jnp.int32) * Q_BLOCK
    kpos = jnp.arange(L, dtype=jnp.int32)

    def one_block(args):
        qblk, cblk, s0 = args
        qpos = s0 + jnp.arange(Q_BLOCK, dtype=jnp.int32)
        return fox_block(qblk, cblk, qpos, k, v, c, kpos)

    ob = lax.map(one_block, (qb, cb, starts))
    return jnp.transpose(ob, (1, 0, 2, 3, 4)).reshape(B, nb * Q_BLOCK, H_A, DH)[:, :L]


def causal_conv(u_full, w):
    L = u_full.shape[1] - (CONV_W - 1)
    y = w[0] * u_full[:, 0:L]
    for i in range(1, CONV_W):
        y = y + w[i] * u_full[:, i:i + L]
    return y


def merge(o_a, za, y_c, zc, w_out):
    B, L = o_a.shape[:2]
    cat = jnp.concatenate([o_a.reshape(B, L, W_A) * jax.nn.silu(za), y_c * jax.nn.silu(zc)], axis=-1)
    return jnp.einsum('blm,md->bld', cat, w_out)


def setup_inputs(seed: int = 0) -> dict:
    key = jax.random.key(seed)
    ks = jax.random.split(key, 16)
    f32 = jnp.float32
    x_prompt = jax.random.normal(ks[0], (BATCH, SEQ, D_MODEL), f32)
    x_sample = jax.random.normal(ks[1], (DEC_BATCH, DEC_SEQ, D_MODEL), f32)
    cache_k = jax.random.normal(ks[2], (DEPTH, DEC_BATCH, PAST_LEN, H_A, DH), f32)
    cache_v = jax.random.normal(ks[3], (DEPTH, DEC_BATCH, PAST_LEN, H_A, DH), f32)
    cache_logf = jax.nn.log_sigmoid(1.0 + jax.random.normal(ks[4], (DEPTH, DEC_BATCH, PAST_LEN, H_A), f32))
    state_conv = jax.random.normal(ks[5], (DEPTH, DEC_BATCH, CONV_W - 1, W_C), f32)
    meta_tokens = jax.random.normal(ks[6], (N_META, D_MODEL), f32)
    norm_g = 1.0 + 0.02 * jax.random.normal(ks[7], (DEPTH, D_MODEL), f32)
    w_in = jax.random.normal(ks[8], (DEPTH, D_MODEL, N_IN), f32) * D_MODEL ** -0.5
    b_f = 1.0 + 0.1 * jax.random.normal(ks[9], (DEPTH, H_A), f32)
    conv_w = jax.random.normal(ks[10], (DEPTH, CONV_W, W_C), f32) * CONV_W ** -0.5
    w_out = jax.random.normal(ks[11], (DEPTH, D_MODEL, D_MODEL), f32) * D_MODEL ** -0.5
    final_g = 1.0 + 0.02 * jax.random.normal(ks[12], (D_MODEL,), f32)
    return {"x_prompt": x_prompt, "x_sample": x_sample, "cache_k": cache_k, "cache_v": cache_v,
            "cache_logf": cache_logf, "state_conv": state_conv, "meta_tokens": meta_tokens,
            "norm_g": norm_g, "w_in": w_in, "b_f": b_f, "conv_w": conv_w, "w_out": w_out,
            "final_g": final_g}


def reference(x_prompt, x_sample, cache_k, cache_v, cache_logf, state_conv, meta_tokens,
              norm_g, w_in, b_f, conv_w, w_out, final_g):
    B = x_prompt.shape[0]
    meta = jnp.broadcast_to(meta_tokens.astype(x_prompt.dtype)[None], (B, N_META, D_MODEL))
    xp = jnp.concatenate([meta, x_prompt], axis=1)
    kp_l, vp_l, fp_l, cp_l = [], [], [], []
    for l in range(DEPTH):
        h = rmsnorm(xp, norm_g[l])
        q, k, v, za, logf, bg, u, zc = project(h, w_in[l], b_f[l])
        o_a = fox_prompt_attention(q, k, v, logf)
        u_full = jnp.pad(u, ((0, 0), (CONV_W - 1, 0), (0, 0)))
        y_c = bg * causal_conv(u_full, conv_w[l])
        xp = xp + merge(o_a, za, y_c, zc, w_out[l])
        kp_l.append(k); vp_l.append(v); fp_l.append(logf); cp_l.append(u[:, -(CONV_W - 1):])
    y_prompt = rmsnorm(xp, final_g)[:, N_META:]

    xs = x_sample
    S = xs.shape[1]
    P = cache_k.shape[2]
    ks_l, vs_l, fs_l, cs_l = [], [], [], []
    for l in range(DEPTH):
        h = rmsnorm(xs, norm_g[l])
        q, k, v, za, logf, bg, u, zc = project(h, w_in[l], b_f[l])
        k_all = jnp.concatenate([cache_k[l].astype(k.dtype), k], axis=1)
        v_all = jnp.concatenate([cache_v[l].astype(v.dtype), v], axis=1)
        c_all = jnp.cumsum(jnp.concatenate([cache_logf[l].astype(jnp.float32), logf], axis=1), axis=1)
        kpos = jnp.arange(P + S, dtype=jnp.int32)
        qpos = P + jnp.arange(S, dtype=jnp.int32)
        o_a = fox_block(q, c_all[:, P:], qpos, k_all, v_all, c_all, kpos)
        u_full = jnp.concatenate([state_conv[l].astype(u.dtype), u], axis=1)
        y_c = bg * causal_conv(u_full, conv_w[l])
        xs = xs + merge(o_a, za, y_c, zc, w_out[l])
        ks_l.append(k); vs_l.append(v); fs_l.append(logf); cs_l.append(u_full[:, -(CONV_W - 1):])
    y_sample = rmsnorm(xs, final_g)

    return (y_prompt, y_sample,
            jnp.stack(kp_l), jnp.stack(vp_l), jnp.stack(fp_l), jnp.stack(cp_l),
            jnp.stack(ks_l), jnp.stack(vs_l), jnp.stack(fs_l), jnp.stack(cs_l))
```

```cpp
#include <hip/hip_runtime.h>
#include <hip/hip_cooperative_groups.h>
#include <cstdio>
#include <cstdint>
namespace cg = cooperative_groups;
namespace pg8 {
#define PG8_LAS __attribute__((address_space(3)))
typedef unsigned short bf16_t;
typedef short bf16x8 __attribute__((ext_vector_type(8)));
typedef float f32x4 __attribute__((ext_vector_type(4)));
typedef unsigned u32x4 __attribute__((ext_vector_type(4)));
constexpr int BM = 256, BK = 64, HALF = 128, HTB = HALF * BK * 2  , STAGE_BYTES = 8 * HTB, NXCD = 8, WGM = 8;

__host__ __device__ __forceinline__ int lds_byte(int r, int c) { const int st = (r >> 4) * 2 + (c >> 5), rr = r & 15, cc = c & 31, ob = rr * 64 + cc * 2; return st * 1024 + (ob ^ (((ob >> 9) & 1) << 5)); }
__host__ __device__ __forceinline__ void stage_rc(int b, int& R, int& C) { const int st = b / 1024, sb = b % 1024, swz = sb ^ (((sb >> 9) & 1) << 5); R = (st >> 1) * 16 + swz / 64; C = (st & 1) * 32 + (swz % 64) / 2; }
__host__ __device__ __forceinline__ int perm32(int rho) { const int n = rho >> 4, i = rho & 15; return 8 * (i >> 2) + 4 * n + (i & 3); }

struct Unit { int pm, pn; };
struct Gemm { const bf16_t* A; const bf16_t* Bt; int M, N, K; };

struct StaticOrder {
    int nM, nN, nwg, G, c, nr, mult;
    __host__ __device__ void init(int M, int N, int G_, int c_, int mult_ = 1) { nM = M / BM; nN = N / BM; nwg = nM * nN; G = G_; c = c_; nr = c < nwg ? (nwg - c + G - 1) / G : 0; mult = mult_; }
    __host__ __device__ bool next(int i, Unit& u) const {
        if (i >= nr * mult) return false;
        const long L = (long)(i % nr) * G + c;
        int wgid = (int)L; { const int q = nwg / NXCD, r = nwg % NXCD, xcd = wgid % NXCD, off = wgid / NXCD; wgid = (xcd < r ? xcd * (q + 1) : r * (q + 1) + (xcd - r) * q) + off; }
        const int nig = WGM * nN, gid = wgid / nig, fm = gid * WGM, gsz = (nM - fm) < WGM ? (nM - fm) : WGM;
        u.pm = fm + ((wgid % nig) % gsz); u.pn = (wgid % nig) / gsz; return true;
    }
    __device__ __forceinline__ void a_ready(const Unit&) const {}
    __device__ __forceinline__ void done(const Unit&) const {}
};

template <class Epi, class Sched, bool ALIGN_EPI = false, bool SP2 = false>
__device__ __forceinline__ void gemm_phase(PG8_LAS unsigned char* lds, const Gemm g, const Sched& S, const Epi& E) {
    const int tid = threadIdx.x, wid = __builtin_amdgcn_readfirstlane(tid >> 6), lane = tid & 63, wr = wid >> 2, wc = wid & 3, fr = lane & 15, fq = lane >> 4;
    const int K = g.K, nt = K / BK;
    unsigned voffA[2], voffB[2];
#pragma unroll
    for (int i = 0; i < 2; ++i) { int R, C; stage_rc(tid * 16 + i * 8192, R, C); const int Rb = Epi::PERM ? ((R & ~31) + perm32(R & 31)) : R;
        voffA[i] = (unsigned)(R * K + C) * 2u; voffB[i] = (unsigned)(Rb * K + C) * 2u; }
    const size_t kstep = (size_t)(BK * 2);
    const size_t hstep = (size_t)HALF * K * 2;
    const size_t tstep = 2 * hstep;
    const unsigned ldsw = (unsigned)wid * 1024u;
    const int aoff = lds_byte(wr * 64 + fr, fq * 8), boff = lds_byte(wc * 32 + fr, fq * 8);
#define PG8_SA(b, h) (((b) * 2 + (h)) * HTB)
#define PG8_SB(b, h) ((4 + (b) * 2 + (h)) * HTB)
#define PG8_STAGE(bufoff, gbase, voff) do { _Pragma("unroll") for (int _i = 0; _i < 2; ++_i) \
        __builtin_amdgcn_global_load_lds((const unsigned*)((const char*)(gbase) + (voff)[_i]), (PG8_LAS unsigned*)(lds + (bufoff) + ldsw + _i * 8192), 16, 0, 0); } while (0)
#define PG8_LDA(dst, b, h) do { _Pragma("unroll") for (int m = 0; m < 4; ++m) _Pragma("unroll") for (int k = 0; k < 2; ++k) dst[m][k] = *(const PG8_LAS bf16x8*)(lds + PG8_SA(b, h) + aoff + m * 2048 + k * 1024); } while (0)
#define PG8_LDB(dst, b, h) do { _Pragma("unroll") for (int n = 0; n < 2; ++n) _Pragma("unroll") for (int k = 0; k < 2; ++k) dst[n][k] = *(const PG8_LAS bf16x8*)(lds + PG8_SB(b, h) + boff + n * 2048 + k * 1024); } while (0)
#define PG8_MMA(ai, bj, At, Bt) do { __builtin_amdgcn_s_setprio(1); _Pragma("unroll") for (int m = 0; m < 4; ++m) _Pragma("unroll") for (int n = 0; n < 2; ++n) _Pragma("unroll") for (int k = 0; k < 2; ++k) \
        acc[ai][bj][m][n] = __builtin_amdgcn_mfma_f32_16x16x32_bf16(Bt[n][k], At[m][k], acc[ai][bj][m][n], 0, 0, 0); __builtin_amdgcn_s_setprio(0); } while (0)
#define PG8_WAIT_V(n) asm volatile("s_waitcnt vmcnt(" #n ")" ::: "memory")
#define PG8_WAIT_L(n) asm volatile("s_waitcnt lgkmcnt(" #n ")" ::: "memory")
#define PG8_BAR __builtin_amdgcn_s_barrier()
#define PG8_SCHED __builtin_amdgcn_sched_barrier(0)
    Unit cur, nxt; int ui = 0;
    if (!S.next(0, cur)) return;
    f32x4 acc[2][2][4][2];
    if constexpr (Epi::INIT_ACC) { E.init_acc(acc, cur, wr, wc, fr, fq); E.after_init(lds); } else {
#pragma unroll
    for (int a = 0; a < 2; ++a)
#pragma unroll
        for (int b = 0; b < 2; ++b)
#pragma unroll
            for (int m = 0; m < 4; ++m)
#pragma unroll
                for (int n = 0; n < 2; ++n) acc[a][b][m][n] = (f32x4){0.f, 0.f, 0.f, 0.f};
    }
    bf16x8 At[4][2], B0[2][2], B1[2][2];
    const char* cA = (const char*)g.A + (size_t)cur.pm * tstep; const char* cB = (const char*)g.Bt + (size_t)cur.pn * tstep;
    S.a_ready(cur);
    if constexpr (SP2) {
        PG8_STAGE(PG8_SB(0, 0), cB, voffB); PG8_STAGE(PG8_SB(0, 1), cB + hstep, voffB); PG8_STAGE(PG8_SA(0, 0), cA, voffA); PG8_STAGE(PG8_SA(0, 1), cA + hstep, voffA);
        if (wr == 1) PG8_BAR;
        PG8_WAIT_V(2); PG8_BAR;
        PG8_STAGE(PG8_SB(1, 0), cB + kstep, voffB); PG8_STAGE(PG8_SA(1, 0), cA + kstep, voffA); PG8_STAGE(PG8_SB(1, 1), cB + hstep + kstep, voffB);
        PG8_WAIT_V(6); PG8_BAR;
    } else {
        PG8_STAGE(PG8_SB(0, 0), cB, voffB); PG8_STAGE(PG8_SA(0, 0), cA, voffA); PG8_STAGE(PG8_SB(0, 1), cB + hstep, voffB); PG8_STAGE(PG8_SA(0, 1), cA + hstep, voffA);
        if (wr == 1) PG8_BAR;
        PG8_WAIT_V(4); PG8_BAR;
        PG8_STAGE(PG8_SB(1, 0), cB + kstep, voffB); PG8_STAGE(PG8_SA(1, 0), cA + kstep, voffA); PG8_STAGE(PG8_SB(1, 1), cB + hstep + kstep, voffB);
        PG8_WAIT_V(6); PG8_BAR;
    }
    for (;;) {
        const bool has_next = S.next(ui + 1, nxt);
        const char* nA = has_next ? (const char*)g.A + (size_t)nxt.pm * tstep : cA; const char* nB = has_next ? (const char*)g.Bt + (size_t)nxt.pn * tstep : cB;
        for (int t = 0; t < nt; t += 2) {
            const bool last = (t == nt - 2);
            const char* a1 = cA + (size_t)(t + 1) * kstep;
            const char* a2 = last ? nA : cA + (size_t)(t + 2) * kstep; const char* b2 = last ? nB : cB + (size_t)(t + 2) * kstep;
            const char* a3 = a2 + kstep; const char* b3 = b2 + kstep;
            if (last && has_next) S.a_ready(nxt);
            if constexpr (SP2) {
            PG8_LDB(B0, 0, 0); PG8_LDB(B1, 0, 1); PG8_SCHED; PG8_LDA(At, 0, 0); PG8_STAGE(PG8_SA(1, 1), a1 + hstep, voffA);
            PG8_WAIT_V(8); PG8_WAIT_L(0); PG8_BAR; PG8_MMA(0, 0, At, B0); PG8_MMA(0, 1, At, B1); PG8_BAR; PG8_SCHED;
            PG8_LDA(At, 0, 1); PG8_STAGE(PG8_SB(0, 0), b2, voffB); PG8_STAGE(PG8_SB(0, 1), b2 + hstep, voffB); PG8_STAGE(PG8_SA(0, 0), a2, voffA);
            PG8_WAIT_V(8); PG8_WAIT_L(0); PG8_BAR; PG8_MMA(1, 0, At, B0); PG8_MMA(1, 1, At, B1); PG8_BAR; PG8_SCHED;
            PG8_LDB(B0, 1, 0); PG8_LDB(B1, 1, 1); PG8_SCHED; PG8_LDA(At, 1, 0); PG8_STAGE(PG8_SA(0, 1), a2 + hstep, voffA);
            PG8_WAIT_V(8); PG8_WAIT_L(0); PG8_BAR; PG8_MMA(0, 0, At, B0); PG8_MMA(0, 1, At, B1); PG8_BAR; PG8_SCHED;
            PG8_LDA(At, 1, 1); PG8_STAGE(PG8_SB(1, 0), b3, voffB); PG8_STAGE(PG8_SB(1, 1), b3 + hstep, voffB); PG8_STAGE(PG8_SA(1, 0), a3, voffA);
            PG8_WAIT_V(8); PG8_WAIT_L(0); PG8_BAR; PG8_MMA(1, 0, At, B0); PG8_MMA(1, 1, At, B1); PG8_BAR; PG8_SCHED;
            } else {
            PG8_LDB(B0, 0, 0); PG8_SCHED; PG8_LDA(At, 0, 0); PG8_STAGE(PG8_SA(1, 1), a1 + hstep, voffA);
            PG8_WAIT_L(8); PG8_BAR; PG8_WAIT_L(0); PG8_MMA(0, 0, At, B0); PG8_BAR; PG8_SCHED;
            PG8_LDB(B1, 0, 1); PG8_STAGE(PG8_SB(0, 0), b2, voffB);
            PG8_BAR; PG8_WAIT_L(0); PG8_MMA(0, 1, At, B1); PG8_BAR;
            PG8_LDA(At, 0, 1); PG8_STAGE(PG8_SA(0, 0), a2, voffA);
            PG8_BAR; PG8_WAIT_L(0); PG8_MMA(1, 0, At, B0); PG8_BAR; PG8_SCHED;
            PG8_STAGE(PG8_SB(0, 1), b2 + hstep, voffB);
            PG8_WAIT_V(6); PG8_BAR; PG8_MMA(1, 1, At, B1); PG8_BAR;
            PG8_LDB(B0, 1, 0); PG8_SCHED; PG8_LDA(At, 1, 0); PG8_STAGE(PG8_SA(0, 1), a2 + hstep, voffA);
            PG8_WAIT_L(8); PG8_BAR; PG8_WAIT_L(0); PG8_MMA(0, 0, At, B0); PG8_BAR; PG8_SCHED;
            PG8_LDB(B1, 1, 1); PG8_STAGE(PG8_SB(1, 0), b3, voffB);
            PG8_BAR; PG8_WAIT_L(0); PG8_MMA(0, 1, At, B1); PG8_BAR;
            PG8_LDA(At, 1, 1); PG8_STAGE(PG8_SA(1, 0), a3, voffA);
            PG8_BAR; PG8_WAIT_L(0); PG8_MMA(1, 0, At, B0); PG8_BAR; PG8_SCHED;
            PG8_STAGE(PG8_SB(1, 1), b3 + hstep, voffB);
            PG8_WAIT_V(6); PG8_BAR; PG8_MMA(1, 1, At, B1); PG8_BAR;
            }
        }
        if constexpr (ALIGN_EPI) { if (wr == 0) PG8_BAR; }
        if constexpr (!Epi::AFTER_DRAIN) { E(acc, cur, wr, wc, fr, fq); S.done(cur); }
        if (!has_next) break;
#pragma unroll
        for (int a = 0; a < 2; ++a)
#pragma unroll
            for (int b = 0; b < 2; ++b)
#pragma unroll
                for (int m = 0; m < 4; ++m)
#pragma unroll
                    for (int n = 0; n < 2; ++n) acc[a][b][m][n] = (f32x4){0.f, 0.f, 0.f, 0.f};
        cur = nxt; cA = nA; cB = nB; ++ui;
        if constexpr (ALIGN_EPI) { if (wr == 1) PG8_BAR; }
    }
    PG8_WAIT_V(0);
    if constexpr (!ALIGN_EPI) { if (wr == 0) PG8_BAR; }
    PG8_BAR;
    if constexpr (Epi::AFTER_DRAIN) { E.fused(acc, cur, wr, wc, fr, fq, lds, wid, lane); S.done(cur); }
#undef PG8_SA
#undef PG8_SB
#undef PG8_STAGE
#undef PG8_LDA
#undef PG8_LDB
#undef PG8_MMA
#undef PG8_WAIT_V
#undef PG8_WAIT_L
#undef PG8_BAR
#undef PG8_SCHED
}
}

#ifndef MK_N_LAUNCHES
#define MK_N_LAUNCHES 1
#endif
#define LAS __attribute__((address_space(3)))
typedef unsigned short bf16_t;
typedef short bf16x8 __attribute__((ext_vector_type(8)));
typedef short s16x4 __attribute__((ext_vector_type(4)));
typedef float f32x4 __attribute__((ext_vector_type(4)));
typedef float f32x2 __attribute__((ext_vector_type(2)));
typedef float f32x16 __attribute__((ext_vector_type(16)));
typedef unsigned u32x4 __attribute__((ext_vector_type(4)));
typedef unsigned u32x2 __attribute__((ext_vector_type(2)));
typedef __bf16 bf16x2_t __attribute__((ext_vector_type(2)));

constexpr int DM = 1024, SEQ = 8192, NMETA = 16, LP = SEQ + NMETA, NB = 2, DBATCH = 16, DSEQ = 16, PAST = 1024, NH = 8, DH = 64, WA = 512, WC = 512, NIN = 4104;
constexpr int NPROW = NB * LP;
constexpr int NSROW = DBATCH * DSEQ;
constexpr int NROW = NPROW + NSROW;
constexpr int MG = NB * SEQ;
constexpr int HROWS = MG + NSROW + NMETA;
constexpr int MOUT = MG + NSROW;
constexpr int LPP = 8320;
constexpr int SPP = 1088;
constexpr int SRC_BG = 2056, SRC_CG = 2568, SRC_HC = 3080, SRC_ZC = 3592, SRC_FL = 2048;
constexpr float LOG2E = 1.4426950408889634f, C2Q = 0.125f * 1.4426950408889634f, EPS = 1e-6f, NEGBIG = -1e30f;

constexpr size_t O_YP = 0, O_YS = 16777216, O_KP = 17039360, O_VP = 25444352, O_FP = 33849344, O_CP = 33980672, O_KS = 33982720, O_VS = 34113792, O_FS = 34244864, O_CS = 34246912;

constexpr size_t MiB = 1u << 20;
constexpr size_t WS_CTL = 0, WS_WIN = 1 * MiB, WS_WOUT = 9 * MiB, WS_H = 11 * MiB, WS_A2 = 44 * MiB, WS_Q = 77 * MiB, WS_K = 94 * MiB, WS_VT = 111 * MiB, WS_SZA = 128 * MiB,
                 WS_U = 145 * MiB, WS_G = 162 * MiB, WS_LOGF = 179 * MiB, WS_C2T = 180 * MiB, WS_C2S = 181 * MiB, WS_SSQ = 182 * MiB, WS_SSQS = 184 * MiB, WS_END = 185 * MiB;
constexpr int CTL_KMAX = 0, CW_BAR = 4096, CW_SEAM = 16384, CW_SEAM2 = 20480, CTL_ZERO_BYTES = 98304;

struct Params {
    const float *x_prompt, *x_sample, *cache_k, *cache_v, *cache_logf, *state_conv, *meta, *norm_g, *w_in, *b_f, *conv_w, *w_out, *final_g;
    float* out; unsigned char* ws; int ph_lo, ph_hi;
};

__device__ __forceinline__ unsigned cvtpk(float lo, float hi) { f32x2 v = {lo, hi}; bf16x2_t b = __builtin_convertvector(v, bf16x2_t); return __builtin_bit_cast(unsigned, b); }
__device__ __forceinline__ float bf2f(unsigned short x) { return __uint_as_float(((unsigned)x) << 16); }
template <int CTRL> __device__ __forceinline__ float dppf(float v) { return __uint_as_float((unsigned)__builtin_amdgcn_update_dpp(0, (int)__float_as_uint(v), CTRL, 0xF, 0xF, true)); }
__device__ __forceinline__ void swap16(float v, float& a, float& b) { const auto rr = __builtin_amdgcn_permlane16_swap(__float_as_uint(v), __float_as_uint(v), false, false); a = __uint_as_float(rr[0]); b = __uint_as_float(rr[1]); }
__device__ __forceinline__ void swap32(float v, float& a, float& b) { const auto rr = __builtin_amdgcn_permlane32_swap(__float_as_uint(v), __float_as_uint(v), false, false); a = __uint_as_float(rr[0]); b = __uint_as_float(rr[1]); }
__device__ __forceinline__ float sum_x16(float v) { float a, b; swap16(v, a, b); return a + b; }
__device__ __forceinline__ float sum_x32(float v) { float a, b; swap32(v, a, b); return a + b; }
__device__ __forceinline__ float max_x16(float v) { float a, b; swap16(v, a, b); return fmaxf(a, b); }
__device__ __forceinline__ float max_x32(float v) { float a, b; swap32(v, a, b); return fmaxf(a, b); }
template <int CTRL, int RMASK> __device__ __forceinline__ float dppz(float v) { return __uint_as_float((unsigned)__builtin_amdgcn_update_dpp(0, (int)__float_as_uint(v), CTRL, RMASK, 0xF, true)); }
__device__ __forceinline__ float wave_iscan(float v) { v += dppz<0x111, 0xF>(v); v += dppz<0x112, 0xF>(v); v += dppz<0x114, 0xF>(v); v += dppz<0x118, 0xF>(v); v += dppz<0x142, 0xA>(v); v += dppz<0x143, 0xC>(v); return v; }
__device__ __forceinline__ float wave_sum(float v) { v += dppf<0xB1>(v); v += dppf<0x4E>(v); v += dppf<0x141>(v); v += dppf<0x140>(v); v = sum_x16(v); return sum_x32(v); }
__device__ __forceinline__ float row16_max(float v) { v = fmaxf(v, dppf<0xB1>(v)); v = fmaxf(v, dppf<0x4E>(v)); v = fmaxf(v, dppf<0x141>(v)); return fmaxf(v, dppf<0x140>(v)); }
__device__ __forceinline__ float wave_max(float v) { v = row16_max(v); v = max_x16(v); return max_x32(v); }
__device__ __forceinline__ float wave_min(float v) { return -wave_max(-v); }
__device__ __forceinline__ float max3f(float a, float b, float c) { float r; asm("v_max3_f32 %0, %1, %2, %3" : "=v"(r) : "v"(a), "v"(b), "v"(c)); return r; }
__device__ __forceinline__ float silu_f(float v) { return v * __builtin_amdgcn_rcpf(1.0f + __builtin_amdgcn_exp2f(v * -1.4426950408889634f)); }
__device__ __forceinline__ int crow(int r, int hi) { return (r & 3) + 8 * (r >> 2) + 4 * hi; }
__device__ __forceinline__ bf16x8 pack8(float a, float b, float c, float d, float e, float f, float g, float h) {
    u32x4 p; p.x = cvtpk(a, b); p.y = cvtpk(c, d); p.z = cvtpk(e, f); p.w = cvtpk(g, h); return __builtin_bit_cast(bf16x8, p); }
#define MFMA32(a, b, c) __builtin_amdgcn_mfma_f32_32x32x16_bf16((a), (b), (c), 0, 0, 0)
#define MFMA16(a, b, c) __builtin_amdgcn_mfma_f32_16x16x32_bf16((a), (b), (c), 0, 0, 0)

__device__ __forceinline__ float* kout_ptr(float* out, int prow) { return prow < NPROW ? out + O_KP + (size_t)prow * 512 : out + O_KS + (size_t)(prow - NPROW) * 512; }
__device__ __forceinline__ float* vout_ptr(float* out, int prow) { return prow < NPROW ? out + O_VP + (size_t)prow * 512 : out + O_VS + (size_t)(prow - NPROW) * 512; }

#define XB_TMO      128
#define XB_XCNT(j)  (256  + 64 * (j))
#define XB_XSUB(j)  (1280 + 64 * (j))
#define XB_XGEN(j)  (2304 + 64 * (j))
#define XB_TOP      3328
#define XB_TOPGEN   3392
#define XCD_BAR_WORDS 3456
#define XB_SPIN_CAP (1u << 18)

__device__ __forceinline__ unsigned xb_ld(unsigned* p)              { return __hip_atomic_load(p, __ATOMIC_RELAXED, __HIP_MEMORY_SCOPE_AGENT); }
__device__ __forceinline__ unsigned xb_add(unsigned* p, unsigned v) { return __hip_atomic_fetch_add(p, v, __ATOMIC_RELAXED, __HIP_MEMORY_SCOPE_AGENT); }
__device__ __forceinline__ unsigned xb_xcc_id() { return (unsigned)__builtin_amdgcn_s_getreg((3 << 11) | 20) & 0xFu; }
#define XB_SPIN(cond, bar) do { unsigned _sp = 0; while (cond) { __builtin_amdgcn_s_sleep(1); \
    if ((++_sp & 255u) == 0u) { if (xb_ld(&(bar)[XB_TMO])) break; if (_sp > XB_SPIN_CAP) { atomicAdd(&(bar)[XB_TMO], 1u); break; } } } } while (0)

struct XcdBarrier {
    unsigned* bar; unsigned x;
    volatile LAS unsigned* st;
};

__device__ __forceinline__ XcdBarrier xcd_barrier_post(unsigned* bar, volatile LAS unsigned* st) {
    XcdBarrier b; b.bar = bar; b.x = xb_xcc_id(); b.st = st;
    if (threadIdx.x == 0) (void)xb_add(&bar[XB_XCNT(b.x)], 1u);
    return b;
}
__device__ __forceinline__ void xcd_barrier_complete(unsigned* bar, unsigned x, unsigned& nloc, unsigned& nx) {
    const unsigned G = gridDim.x * gridDim.y * gridDim.z;
    unsigned sum, cnt, mine, sp = 0u;
    for (;;) {
        sum = 0u; cnt = 0u; mine = 0u;
#pragma unroll
        for (unsigned j = 0; j < 16; ++j) { const unsigned c = xb_ld(&bar[XB_XCNT(j)]); sum += c; cnt += (c > 0u) ? 1u : 0u; mine = (j == x) ? c : mine; }
        if (sum == G) break;
        __builtin_amdgcn_s_sleep(1);
        if ((++sp & 255u) == 0u) { if (xb_ld(&bar[XB_TMO])) break; if (sp > XB_SPIN_CAP) { atomicAdd(&bar[XB_TMO], 1u); break; } }
    }
    nloc = mine > 0u ? mine : 1u; nx = cnt > 0u ? cnt : 1u;
}

__device__ __forceinline__ void xcd_barrier(const XcdBarrier& b) {
    asm volatile("s_waitcnt vmcnt(0)" ::: "memory");
    __syncthreads();
    if (threadIdx.x == 0) {
        unsigned* bar = b.bar;
        __builtin_amdgcn_s_waitcnt(0);
        unsigned nloc = b.st[0], nx = b.st[1];
        if (nloc == 0u) { xcd_barrier_complete(bar, b.x, nloc, nx); b.st[0] = nloc; b.st[1] = nx; }
        const unsigned old = xb_add(&bar[XB_XSUB(b.x)], 1u);
        const unsigned gen = old / nloc;
        if (old + 1u == (gen + 1u) * nloc) {
            __builtin_amdgcn_fence(__ATOMIC_RELEASE, "agent");
            asm volatile("s_waitcnt vmcnt(0)" ::: "memory");
            const unsigned og = xb_add(&bar[XB_TOP], 1u);
            const unsigned tg = og / nx;
            if (og + 1u == (tg + 1u) * nx) xb_add(&bar[XB_TOPGEN], 1u);
            else XB_SPIN(xb_ld(&bar[XB_TOPGEN]) == tg, bar);
            __builtin_amdgcn_fence(__ATOMIC_ACQUIRE, "agent");
            xb_add(&bar[XB_XGEN(b.x)], 1u);
            asm volatile("s_waitcnt vmcnt(0)" ::: "memory");
        } else {
            XB_SPIN(xb_ld(&bar[XB_XGEN(b.x)]) == gen, bar);
            __builtin_amdgcn_fence(__ATOMIC_ACQUIRE, "agent");
            asm volatile("s_waitcnt vmcnt(0)" ::: "memory");
        }
    }
    __syncthreads();
}

struct Sink {
    float* out; bf16_t *Qb, *Kb, *Vt, *SZA, *U, *Gg;
    template <int cls> __device__ __forceinline__ void put(int prow, int c, f32x4 v, f32x4 w) const {
        if constexpr (cls == 0) { u32x2 o; o.x = cvtpk(v[0] * C2Q, v[1] * C2Q); o.y = cvtpk(v[2] * C2Q, v[3] * C2Q); *(u32x2*)(Qb + (size_t)prow * 512 + c) = o; }
        else if constexpr (cls == 1) { u32x2 o; o.x = cvtpk(v[0], v[1]); o.y = cvtpk(v[2], v[3]); *(u32x2*)(Kb + (size_t)prow * 512 + c) = o; *(f32x4*)(kout_ptr(out, prow) + c) = v; }
        else if constexpr (cls == 2) {
            *(f32x4*)(vout_ptr(out, prow) + c) = v;
            if (prow < NPROW) { const int b = prow >= LP ? 1 : 0, pos = prow - b * LP; bf16_t* p = Vt + (size_t)(b * 512 + c) * LPP + pos;
                const unsigned a = cvtpk(v[0], v[1]), d = cvtpk(v[2], v[3]);
                p[0] = (bf16_t)(a & 0xffffu); p[LPP] = (bf16_t)(a >> 16); p[2 * LPP] = (bf16_t)(d & 0xffffu); p[3 * LPP] = (bf16_t)(d >> 16); }
        }
        else if constexpr (cls == 3) { u32x2 o; o.x = cvtpk(silu_f(v[0]), silu_f(v[1])); o.y = cvtpk(silu_f(v[2]), silu_f(v[3])); *(u32x2*)(SZA + (size_t)prow * 512 + c) = o; }
        else if constexpr (cls == 4) { const f32x4 uu = v * w; u32x2 o; o.x = cvtpk(uu[0], uu[1]); o.y = cvtpk(uu[2], uu[3]); *(u32x2*)(U + (size_t)prow * 512 + c) = o;
            if (prow < NPROW) { const int b = prow >= LP ? 1 : 0, pos = prow - b * LP; if (pos >= LP - 2) *(f32x4*)(out + O_CP + (size_t)(b * 2 + (pos - (LP - 2))) * 512 + c) = uu; }
            else { const int sr = prow - NPROW, s = sr & 15; if (s >= 14) *(f32x4*)(out + O_CS + (size_t)((sr >> 4) * 2 + (s - 14)) * 512 + c) = uu; } }
        else { u32x2 o; o.x = cvtpk(v[0] * silu_f(w[0]), v[1] * silu_f(w[1])); o.y = cvtpk(v[2] * silu_f(w[2]), v[3] * silu_f(w[3])); *(u32x2*)(Gg + (size_t)prow * 512 + c) = o; }
    }
    template <int cls> __device__ __forceinline__ void put8(int prow, int c, f32x4 v0, f32x4 v1, f32x4 w0, f32x4 w1) const {
        if constexpr (cls == 0) { u32x4 o; o.x = cvtpk(v0[0] * C2Q, v0[1] * C2Q); o.y = cvtpk(v0[2] * C2Q, v0[3] * C2Q); o.z = cvtpk(v1[0] * C2Q, v1[1] * C2Q); o.w = cvtpk(v1[2] * C2Q, v1[3] * C2Q); *(u32x4*)(Qb + (size_t)prow * 512 + c) = o; }
        else if constexpr (cls == 1) { u32x4 o; o.x = cvtpk(v0[0], v0[1]); o.y = cvtpk(v0[2], v0[3]); o.z = cvtpk(v1[0], v1[1]); o.w = cvtpk(v1[2], v1[3]); *(u32x4*)(Kb + (size_t)prow * 512 + c) = o;
            float* kp = kout_ptr(out, prow) + c; *(f32x4*)kp = v0; *(f32x4*)(kp + 4) = v1; }
        else if constexpr (cls == 2) { float* vp = vout_ptr(out, prow) + c; *(f32x4*)vp = v0; *(f32x4*)(vp + 4) = v1;
            { const int b = prow >= LP ? 1 : 0, pos = prow - b * LP, odd = pos & 1; unsigned* p = (unsigned*)(Vt + (size_t)(b * 512 + c + odd) * LPP + (pos & ~1));
                const unsigned pk[4] = {cvtpk(v0[0], v0[1]), cvtpk(v0[2], v0[3]), cvtpk(v1[0], v1[1]), cvtpk(v1[2], v1[3])};
#pragma unroll
                for (int i = 0; i < 4; ++i) { const unsigned y = (unsigned)__builtin_amdgcn_update_dpp(0, (int)pk[i], 0xB1, 0xF, 0xF, true);
                    const unsigned o = odd ? ((y >> 16) | (pk[i] & 0xffff0000u)) : ((pk[i] & 0xffffu) | (y << 16));
                    p[(size_t)i * LPP] = o; } } }
        else if constexpr (cls == 3) { u32x4 o; o.x = cvtpk(silu_f(v0[0]), silu_f(v0[1])); o.y = cvtpk(silu_f(v0[2]), silu_f(v0[3])); o.z = cvtpk(silu_f(v1[0]), silu_f(v1[1])); o.w = cvtpk(silu_f(v1[2]), silu_f(v1[3])); *(u32x4*)(SZA + (size_t)prow * 512 + c) = o; }
        else if constexpr (cls == 4) { const f32x4 u0 = v0 * w0, u1 = v1 * w1; u32x4 o; o.x = cvtpk(u0[0], u0[1]); o.y = cvtpk(u0[2], u0[3]); o.z = cvtpk(u1[0], u1[1]); o.w = cvtpk(u1[2], u1[3]); *(u32x4*)(U + (size_t)prow * 512 + c) = o;
            if (prow < NPROW) { const int b = prow >= LP ? 1 : 0, pos = prow - b * LP; if (pos >= LP - 2) { float* cp = out + O_CP + (size_t)(b * 2 + (pos - (LP - 2))) * 512 + c; *(f32x4*)cp = u0; *(f32x4*)(cp + 4) = u1; } } }
        else { u32x4 o; o.x = cvtpk(v0[0] * silu_f(w0[0]), v0[1] * silu_f(w0[1])); o.y = cvtpk(v0[2] * silu_f(w0[2]), v0[3] * silu_f(w0[3])); o.z = cvtpk(v1[0] * silu_f(w1[0]), v1[1] * silu_f(w1[1])); o.w = cvtpk(v1[2] * silu_f(w1[2]), v1[3] * silu_f(w1[3])); *(u32x4*)(Gg + (size_t)prow * 512 + c) = o; }
    }
};

__device__ __forceinline__ void mini_out_begin(const Params& P, LAS unsigned char* lds);
namespace pg8 {
struct EpiIn {
    static constexpr bool PERM = true, AFTER_DRAIN = false, INIT_ACC = false;
    Sink S; unsigned* kmax;
    template <int CLS> __device__ __forceinline__ void single(const f32x4 (&acc)[2][2][4][2], const Unit& u, int wr, int wc, int fr, int fq) const {
        const int pn = u.pn, b = u.pm >> 5, rbase = u.pm * BM + wr * 64 + fr, cb = (pn & 1) * 256 + wc * 32 + 8 * fq;
        float kq[2] = {0.f, 0.f};
#pragma unroll
        for (int ai = 0; ai < 2; ++ai)
#pragma unroll
            for (int m = 0; m < 4; ++m) { const int R = rbase + ai * HALF + m * 16; const int prow = b * LP + NMETA + (R & (SEQ - 1));
#pragma unroll
                for (int bj = 0; bj < 2; ++bj) { const f32x4 v0 = acc[ai][bj][m][0], v1 = acc[ai][bj][m][1]; S.template put8<CLS>(prow, cb + bj * HALF, v0, v1, v0, v1);
                    if constexpr (CLS == 1) { const float s = ((v0[0] * v0[0] + v0[1] * v0[1]) + (v0[2] * v0[2] + v0[3] * v0[3])) + ((v1[0] * v1[0] + v1[1] * v1[1]) + (v1[2] * v1[2] + v1[3] * v1[3])); kq[bj] = fmaxf(kq[bj], s); } } }
        if constexpr (CLS == 1) {
#pragma unroll
            for (int bj = 0; bj < 2; ++bj) { float s = sum_x16(kq[bj]); s = row16_max(s);
                const int head = (pn & 1) * 4 + 2 * bj + (wc >> 1), quarter = 2 * (wc & 1) + (fq >> 1);
                if (fr == 0 && (fq & 1) == 0) atomicMax(kmax + (b * 8 + head) * 4 + quarter, __float_as_uint(s)); }
        }
    }
    template <int CLS> __device__ __forceinline__ void paired(const f32x4 (&acc)[2][2][4][2], const Unit& u, int wr, int wc, int fr, int fq) const {
        const int pn = u.pn, b = u.pm >> 5, rbase = u.pm * BM + wr * 64 + fr, cb = ((pn - 8) & 3) * 128 + wc * 32 + 8 * fq;
#pragma unroll
        for (int ai = 0; ai < 2; ++ai)
#pragma unroll
            for (int m = 0; m < 4; ++m) { const int R = rbase + ai * HALF + m * 16; const int prow = b * LP + NMETA + (R & (SEQ - 1));
                S.template put8<CLS>(prow, cb, acc[ai][0][m][0], acc[ai][0][m][1], acc[ai][1][m][0], acc[ai][1][m][1]); }
    }
    __device__ __forceinline__ void operator()(const f32x4 (&acc)[2][2][4][2], const Unit& u, int wr, int wc, int fr, int fq) const {
        const int pn = u.pn;
        if (pn < 2) single<0>(acc, u, wr, wc, fr, fq); else if (pn < 4) single<1>(acc, u, wr, wc, fr, fq); else if (pn < 6) single<2>(acc, u, wr, wc, fr, fq); else if (pn < 8) single<3>(acc, u, wr, wc, fr, fq);
        else if (pn < 12) paired<4>(acc, u, wr, wc, fr, fq); else paired<5>(acc, u, wr, wc, fr, fq);
    }
};
struct EpiOut {
    static constexpr bool PERM = false, AFTER_DRAIN = false, INIT_ACC = false;
    const float* x; float* y; float* ssq;
    __device__ __forceinline__ void operator()(const f32x4 (&acc)[2][2][4][2], const Unit& u, int wr, int wc, int fr, int fq) const {
        const int col0 = u.pn * BM + wc * 32 + 4 * fq;
#pragma unroll
        for (int ai = 0; ai < 2; ++ai)
#pragma unroll
            for (int m = 0; m < 4; ++m) { const int R = u.pm * BM + ai * HALF + wr * 64 + m * 16 + fr; const size_t off = (size_t)R * DM + col0; float s = 0.f;
#pragma unroll
                for (int bj = 0; bj < 2; ++bj)
#pragma unroll
                    for (int n = 0; n < 2; ++n) { const f32x4 xv = *(const f32x4*)(x + off + bj * HALF + n * 16); const f32x4 o = xv + acc[ai][bj][m][n];
                        *(f32x4*)(y + off + bj * HALF + n * 16) = o; s += (o[0] * o[0] + o[1] * o[1]) + (o[2] * o[2] + o[3] * o[3]); }
                s = sum_x32(sum_x16(s));
                if (fq == 0) ssq[(size_t)R * 16 + u.pn * 4 + wc] = s; }
    }
};
struct EpiOutNorm {
    static constexpr bool PERM = false, AFTER_DRAIN = true, INIT_ACC = true;
    const float* x; float* y; const float* g; unsigned* xbuf; unsigned* cnt; const Params* prm;
    __device__ __forceinline__ void after_init(PG8_LAS unsigned char* lds) const { mini_out_begin(*prm, lds); __syncthreads(); }
    __device__ __forceinline__ void init_acc(f32x4 (&acc)[2][2][4][2], const Unit& u, int wr, int wc, int fr, int fq) const {
        const int col0 = u.pn * BM + wc * 32 + 4 * fq;
#pragma unroll
        for (int ai = 0; ai < 2; ++ai)
#pragma unroll
            for (int m = 0; m < 4; ++m) { const size_t off = (size_t)(u.pm * BM + ai * HALF + wr * 64 + m * 16 + fr) * DM + col0;
#pragma unroll
                for (int bj = 0; bj < 2; ++bj)
#pragma unroll
                    for (int n = 0; n < 2; ++n) acc[ai][bj][m][n] = *(const f32x4*)(x + off + bj * HALF + n * 16); }
    }
    __device__ __forceinline__ void fused(f32x4 (&acc)[2][2][4][2], const Unit& u, int wr, int wc, int fr, int fq, PG8_LAS unsigned char* lds, int wid, int lane) const {
        PG8_LAS float* Pp = (PG8_LAS float*)lds; PG8_LAS float* Sr = (PG8_LAS float*)(lds + 4096);
        const int col0 = u.pn * BM + wc * 32 + 4 * fq;
#pragma unroll
        for (int ai = 0; ai < 2; ++ai)
#pragma unroll
            for (int m = 0; m < 4; ++m) { const int rl = ai * HALF + wr * 64 + m * 16 + fr; float s = 0.f;
#pragma unroll
                for (int bj = 0; bj < 2; ++bj)
#pragma unroll
                    for (int n = 0; n < 2; ++n) { const f32x4 o = acc[ai][bj][m][n]; const f32x4 q = o * o; s += (q[0] + q[1]) + (q[2] + q[3]); }
                s = sum_x32(sum_x16(s));
                if (fq == 0) Pp[rl * 4 + wc] = s; }
        asm volatile("s_waitcnt lgkmcnt(0)" ::: "memory"); __builtin_amdgcn_s_barrier(); asm volatile("" ::: "memory");
        const int row = wid * 32 + (lane & 31);
        if (lane < 32) { const float tot = (Pp[row * 4] + Pp[row * 4 + 1]) + (Pp[row * 4 + 2] + Pp[row * 4 + 3]);
            __hip_atomic_store(xbuf + (size_t)(u.pm * BM + row) * 4 + u.pn, __float_as_uint(tot), __ATOMIC_RELAXED, __HIP_MEMORY_SCOPE_AGENT); }
        asm volatile("s_waitcnt vmcnt(0)" ::: "memory");
        if (lane == 0) __hip_atomic_fetch_add(cnt + 64 * u.pm, 1u, __ATOMIC_RELAXED, __HIP_MEMORY_SCOPE_AGENT);
        if (wid == 0) { unsigned sp = 0;
            while ((unsigned)__builtin_amdgcn_readfirstlane(__hip_atomic_load(cnt + 64 * u.pm, __ATOMIC_RELAXED, __HIP_MEMORY_SCOPE_AGENT)) < 32u) { __builtin_amdgcn_s_sleep(2); if (++sp > (1u << 22)) break; }
            __builtin_amdgcn_fence(__ATOMIC_ACQUIRE, "agent"); }
        asm volatile("s_waitcnt vmcnt(0) lgkmcnt(0)" ::: "memory"); __builtin_amdgcn_s_barrier(); asm volatile("" ::: "memory");
        if (lane < 32) { const unsigned* slot = xbuf + (size_t)(u.pm * BM + row) * 4; float t = 0.f;
#pragma unroll
            for (int k = 0; k < 4; ++k) t += __uint_as_float(__hip_atomic_load(slot + k, __ATOMIC_RELAXED, __HIP_MEMORY_SCOPE_AGENT));
            Sr[row] = 1.0f / sqrtf(t * (1.0f / DM) + EPS); }
        asm volatile("s_waitcnt lgkmcnt(0)" ::: "memory"); __builtin_amdgcn_s_barrier(); asm volatile("" ::: "memory");
        f32x4 gv[2][2];
#pragma unroll
        for (int bj = 0; bj < 2; ++bj)
#pragma unroll
            for (int n = 0; n < 2; ++n) gv[bj][n] = *(const f32x4*)(g + col0 + bj * HALF + n * 16);
#pragma unroll
        for (int ai = 0; ai < 2; ++ai)
#pragma unroll
            for (int m = 0; m < 4; ++m) { const int rl = ai * HALF + wr * 64 + m * 16 + fr; const size_t off = (size_t)(u.pm * BM + rl) * DM + col0; const float rs = Sr[rl];
#pragma unroll
                for (int bj = 0; bj < 2; ++bj)
#pragma unroll
                    for (int n = 0; n < 2; ++n) *(f32x4*)(y + off + bj * HALF + n * 16) = acc[ai][bj][m][n] * rs * gv[bj][n]; }
    }
};
}

__device__ __forceinline__ void mini_mma(const bf16_t* A0, const bf16_t* W0, const bf16_t* W1, int lane, f32x4& acc0, f32x4& acc1) {
    const int fr = lane & 15, fq = lane >> 4;
    const bf16_t* ap = A0 + (size_t)fr * DM + 8 * fq; const bf16_t* w0 = W0 + (size_t)fr * DM + 8 * fq; const bf16_t* w1 = W1 + (size_t)fr * DM + 8 * fq;
    acc0 = (f32x4){0.f, 0.f, 0.f, 0.f}; acc1 = acc0;
#pragma unroll 8
    for (int k = 0; k < DM; k += 32) {
        const bf16x8 a = *(const bf16x8*)(ap + k), b0 = *(const bf16x8*)(w0 + k), b1 = *(const bf16x8*)(w1 + k);
        acc0 = MFMA16(b0, a, acc0); acc1 = MFMA16(b1, a, acc1);
    }
}

constexpr int MW_STRIDE = 2064;
__device__ __forceinline__ void mini_stage_w(LAS unsigned char* lds, const bf16_t* WT, int c0, int c1) {
    const int tid = threadIdx.x;
    u32x4 v[8];
#pragma unroll
    for (int i = 0; i < 8; ++i) { const int id = tid + 512 * i, row = id >> 7, ch = id & 127; v[i] = *(const u32x4*)(WT + (size_t)(row < 16 ? c0 + row : c1 + row - 16) * DM + ch * 8); }
#pragma unroll
    for (int i = 0; i < 8; ++i) { const int id = tid + 512 * i, row = id >> 7, ch = id & 127; *(LAS u32x4*)(lds + row * MW_STRIDE + ch * 16) = v[i]; }
}
__device__ __forceinline__ void mini_load_a(const bf16_t* A0, int lane, int kh, bf16x8 (&a)[16]) {
    const bf16_t* ap = A0 + (size_t)(lane & 15) * DM + 8 * (lane >> 4) + 512 * kh;
#pragma unroll
    for (int k = 0; k < 16; ++k) a[k] = *(const bf16x8*)(ap + 32 * k);
}
__device__ __forceinline__ void mini_mma_lds(const LAS unsigned char* lds, const bf16x8 (&a)[16], int lane, int kh, f32x4& acc0, f32x4& acc1) {
    const LAS unsigned char* w0 = lds + (lane & 15) * MW_STRIDE + (lane >> 4) * 16 + 1024 * kh; const LAS unsigned char* w1 = w0 + 16 * MW_STRIDE;
#pragma unroll
    for (int k = 0; k < 16; ++k) { const bf16x8 b0 = *(const LAS bf16x8*)(w0 + 64 * k), b1 = *(const LAS bf16x8*)(w1 + 64 * k); acc0 = MFMA16(b0, a[k], acc0); acc1 = MFMA16(b1, a[k], acc1); }
}

__device__ __forceinline__ unsigned f2bf(float f) { unsigned u = __builtin_bit_cast(unsigned, f); return (u + 0x7fffu + ((u >> 16) & 1u)) >> 16; }
__device__ __forceinline__ unsigned pk2(float lo, float hi) { return f2bf(lo) | (f2bf(hi) << 16); }
__device__ __forceinline__ void transpose_item(const float* W, int ldw, int src0, bf16_t* WT, int dst0, int k0, LAS float* scr, int lane) {
    float tv[32];
#pragma unroll
    for (int i = 0; i < 32; ++i) { const int kk = 2 * i + (lane >> 5); tv[i] = W[(size_t)(k0 + kk) * ldw + src0 + (lane & 31)]; }
#pragma unroll
    for (int i = 0; i < 32; ++i) { const int kk = 2 * i + (lane >> 5); scr[kk * 33 + (lane & 31)] = tv[i]; }
    asm volatile("s_waitcnt lgkmcnt(0)" ::: "memory");
    const int c = lane & 7;
#pragma unroll
    for (int j = 0; j < 4; ++j) { const int n = (lane >> 3) + 8 * j; const LAS float* s = scr + (8 * c) * 33 + n;
        u32x4 o; o.x = cvtpk(s[0 * 33], s[1 * 33]); o.y = cvtpk(s[2 * 33], s[3 * 33]); o.z = cvtpk(s[4 * 33], s[5 * 33]); o.w = cvtpk(s[6 * 33], s[7 * 33]);
        *(u32x4*)(WT + (size_t)(dst0 + n) * DM + k0 + 8 * c) = o; }
    asm volatile("s_waitcnt lgkmcnt(0)" ::: "memory");
}
__device__ __forceinline__ int in_srccol(int n0) { const int tile = n0 >> 8, c = n0 & 255;
    if (tile < 8) return n0;
    if (tile < 12) { const int j = tile - 8; return c < 128 ? SRC_CG + 128 * j + c : SRC_HC + 128 * j + (c - 128); }
    const int j = tile - 12; return c < 128 ? SRC_BG + 128 * j + c : SRC_ZC + 128 * j + (c - 128); }

__device__ __forceinline__ void phase0(const Params& P, LAS unsigned char* lds) {
    const int tid = threadIdx.x, lane = tid & 63, wave = __builtin_amdgcn_readfirstlane(tid >> 6), G = gridDim.x, blk = blockIdx.x;
    unsigned char* ws = P.ws;
    bf16_t* WinT = (bf16_t*)(ws + WS_WIN); bf16_t* WoutT = (bf16_t*)(ws + WS_WOUT); bf16_t* H = (bf16_t*)(ws + WS_H); bf16_t* Vt = (bf16_t*)(ws + WS_VT);
    float* LOGF = (float*)(ws + WS_LOGF);
    for (int i = blk * 512 + tid; i < 1024 * 14; i += G * 512) { const int row = i / 14, ch = i % 14; *(u32x4*)(Vt + (size_t)row * LPP + LP + ch * 8) = (u32x4){0u, 0u, 0u, 0u}; }
    LAS float* wft = (LAS float*)(lds + 81920);
    for (int i = tid; i < 8192; i += 512) { const int k = i >> 3, e = i & 7; wft[e * 1024 + k] = P.w_in[(size_t)k * NIN + SRC_FL + e]; }
    LAS float* scr = (LAS float*)(lds + wave * 8448);
    const int gw = blk * 8 + wave, NGW = G * 8;
    for (int it = gw; it < 2048; it += NGW) { const int kb = it >> 7, nb = it & 127; transpose_item(P.w_in, NIN, in_srccol(nb * 32), WinT, nb * 32, kb * 64, scr, lane); }
    (void)WoutT;
    __syncthreads();
    f32x4 gv[4];
#pragma unroll
    for (int j = 0; j < 4; ++j) gv[j] = ((const f32x4*)P.norm_g)[lane + 64 * j];
    for (int Ra = gw; Ra < HROWS; Ra += 2 * NGW) {
        const int Rb = Ra + NGW; const bool hasb = Rb < HROWS; const int Rbb = hasb ? Rb : Ra;
        auto xrow = [&](int R) { return R < MG ? P.x_prompt + (size_t)R * DM : (R < MOUT ? P.x_sample + (size_t)(R - MG) * DM : P.meta + (size_t)(R - MOUT) * DM); };
        const float* xa = xrow(Ra); const float* xb = xrow(Rbb);
        f32x4 va[4], vb[4]; float sa = 0.f, sb = 0.f;
#pragma unroll
        for (int j = 0; j < 4; ++j) { va[j] = ((const f32x4*)xa)[lane + 64 * j]; vb[j] = ((const f32x4*)xb)[lane + 64 * j]; }
#pragma unroll
        for (int j = 0; j < 4; ++j) { const f32x4 qa = va[j] * va[j], qb = vb[j] * vb[j]; sa += (qa[0] + qa[1]) + (qa[2] + qa[3]); sb += (qb[0] + qb[1]) + (qb[2] + qb[3]); }
        sa = wave_sum(sa); sb = wave_sum(sb);
        const float ra = __builtin_amdgcn_rsqf(sa * (1.0f / DM) + EPS), rb = __builtin_amdgcn_rsqf(sb * (1.0f / DM) + EPS);
#pragma unroll
        for (int j = 0; j < 4; ++j) { va[j] = va[j] * ra * gv[j]; vb[j] = vb[j] * rb * gv[j];
            u32x2 o; o.x = cvtpk(va[j][0], va[j][1]); o.y = cvtpk(va[j][2], va[j][3]); *(u32x2*)(H + (size_t)Ra * DM + 4 * lane + 256 * j) = o;
            if (hasb) { u32x2 q; q.x = cvtpk(vb[j][0], vb[j][1]); q.y = cvtpk(vb[j][2], vb[j][3]); *(u32x2*)(H + (size_t)Rb * DM + 4 * lane + 256 * j) = q; } }
        float r1[8];
#pragma unroll
        for (int e = 0; e < 8; ++e) { f32x2 a2 = {0.f, 0.f}, c2 = {0.f, 0.f};
#pragma unroll
            for (int j = 0; j < 4; ++j) { const f32x4 wv = *(const LAS f32x4*)(wft + e * 1024 + 256 * j + 4 * lane);
                const f32x2 w01 = {wv[0], wv[1]}, w23 = {wv[2], wv[3]};
                a2 = (f32x2){va[j][0], va[j][1]} * w01 + a2; a2 = (f32x2){va[j][2], va[j][3]} * w23 + a2;
                c2 = (f32x2){vb[j][0], vb[j][1]} * w01 + c2; c2 = (f32x2){vb[j][2], vb[j][3]} * w23 + c2; }
            const auto rr = __builtin_amdgcn_permlane32_swap(__float_as_uint(a2[0] + a2[1]), __float_as_uint(c2[0] + c2[1]), false, false);
            r1[e] = __uint_as_float(rr[0]) + __uint_as_float(rr[1]); }
        float r2[4];
#pragma unroll
        for (int i = 0; i < 4; ++i) { const auto rr = __builtin_amdgcn_permlane16_swap(__float_as_uint(r1[2 * i]), __float_as_uint(r1[2 * i + 1]), false, false);
            float v = __uint_as_float(rr[0]) + __uint_as_float(rr[1]);
            v += dppf<0xB1>(v); v += dppf<0x4E>(v); v += dppf<0x141>(v); v += dppf<0x140>(v); r2[i] = v; }
        { const int i4 = lane & 15, rho = lane >> 4;
          float val = r2[0]; val = i4 == 1 ? r2[1] : val; val = i4 == 2 ? r2[2] : val; val = i4 == 3 ? r2[3] : val;
          if (i4 < 4) {
            const int e = 2 * i4 + (rho & 1); const bool isb = rho >= 2; const int R = isb ? Rb : Ra;
            if (!isb || hasb) {
                const float yv = val + P.b_f[e];
                const float lf = fminf(yv, 0.f) - __logf(1.0f + __expf(-fabsf(yv)));
                if (R < MG) { const int b = R >> 13, prow = b * LP + NMETA + (R & (SEQ - 1)); LOGF[(size_t)prow * 8 + e] = lf; P.out[O_FP + (size_t)prow * 8 + e] = lf; }
                else if (R < MOUT) { const int sr = R - MG; LOGF[(size_t)(NPROW + sr) * 8 + e] = lf; P.out[O_FS + (size_t)sr * 8 + e] = lf; }
                else { const int j = R - MOUT;
#pragma unroll
                    for (int b = 0; b < 2; ++b) { const int prow = b * LP + j; LOGF[(size_t)prow * 8 + e] = lf; P.out[O_FP + (size_t)prow * 8 + e] = lf; } }
            } } }
    }
}

__device__ __forceinline__ void mini_inproj(const Params& P, const Sink& S, unsigned* kmax, LAS unsigned char* lds) {
    const int tid = threadIdx.x, lane = tid & 63, wave = __builtin_amdgcn_readfirstlane(tid >> 6), G = gridDim.x, fr = lane & 15, fq = lane >> 4;
    const bf16_t* WinT = (const bf16_t*)(P.ws + WS_WIN); const bf16_t* H = (const bf16_t*)(P.ws + WS_H);
    for (int it = blockIdx.x; it < 256; it += G) {
        const int p = it >> 1, half = it & 1;
        int c0, c1, cls, cc;
        if (p < 64) { c0 = 32 * p; c1 = c0 + 16; cls = c0 >> 9; cc = c0 & 511; }
        else { const int pp = p - 64, tile = 8 + (pp >> 3), sub = pp & 7; c0 = tile * 256 + 16 * sub; c1 = c0 + 128; cls = tile < 12 ? 4 : 5; cc = ((tile - 8) & 3) * 128 + 16 * sub; }
        const int nrf = (half == 0 && wave == 0) ? 2 : 1;
        __syncthreads();
        mini_stage_w(lds, WinT, c0, c1);
        __syncthreads();
#pragma unroll 1
        for (int q = 0; q < nrf; ++q) {
            asm volatile("" ::: "memory");
            const int rf = half == 0 ? (q == 0 ? wave : 8) : 9 + wave;
            const bf16_t* Ar = H + (size_t)(MG + 16 * rf) * DM;
            bf16x8 af[16], ag[16];
            mini_load_a(Ar, lane, 0, af);
            mini_load_a(Ar, lane, 1, ag);
            f32x4 a0 = (f32x4){0.f, 0.f, 0.f, 0.f}, a1 = a0;
            mini_mma_lds(lds, af, lane, 0, a0, a1);
            mini_mma_lds(lds, ag, lane, 1, a0, a1);
            const int R = MG + 16 * rf + fr;
            const bool meta = R >= MOUT;
            const int prow = meta ? (R - MOUT) : NPROW + (R - MG);
#define MINI_PUT1(C) do { S.put<C>(prow, cc + 4 * fq, a0, a0); S.put<C>(prow, cc + 16 + 4 * fq, a1, a1); if (meta) { S.put<C>(prow + LP, cc + 4 * fq, a0, a0); S.put<C>(prow + LP, cc + 16 + 4 * fq, a1, a1); } } while (0)
#define MINI_PUT2(C) do { S.put<C>(prow, cc + 4 * fq, a0, a1); if (meta) S.put<C>(prow + LP, cc + 4 * fq, a0, a1); } while (0)
            switch (cls) { case 0: MINI_PUT1(0); break; case 1: MINI_PUT1(1); break; case 2: MINI_PUT1(2); break; case 3: MINI_PUT1(3); break; case 4: MINI_PUT2(4); break; default: MINI_PUT2(5); break; }
#undef MINI_PUT1
#undef MINI_PUT2
            if (cls == 1 && rf == 16) {
                float s0 = (a0[0] * a0[0] + a0[1] * a0[1]) + (a0[2] * a0[2] + a0[3] * a0[3]), s1 = (a1[0] * a1[0] + a1[1] * a1[1]) + (a1[2] * a1[2] + a1[3] * a1[3]);
                s0 = sum_x32(sum_x16(s0)); s1 = sum_x32(sum_x16(s1));
                s0 = row16_max(s0); s1 = row16_max(s1);
                if (lane == 0) { const int head = cc >> 6, qr = (cc >> 4) & 3;
                    atomicMax(kmax + (0 * 8 + head) * 4 + qr, __float_as_uint(s0)); atomicMax(kmax + (1 * 8 + head) * 4 + qr, __float_as_uint(s0));
                    atomicMax(kmax + (0 * 8 + head) * 4 + qr + 1, __float_as_uint(s1)); atomicMax(kmax + (1 * 8 + head) * 4 + qr + 1, __float_as_uint(s1)); }
            }
        }
    }
}

template <int NR, class GET> __device__ __forceinline__ float scan_load(float (&x)[NR], int row0, GET get, int lane) {
    float t = 0.f;
#pragma unroll
    for (int k = 0; k < NR; ++k) { x[k] = get(64 * (row0 + k) + lane); t += x[k]; }
    return t;
}
template <int NR> __device__ __forceinline__ void scan_store(const float (&x)[NR], int row0, int nrows, float carry, float* out, int lane) {
#pragma unroll
    for (int k = 0; k < NR; ++k) { if (row0 + k < nrows) { float inc = x[k];
            inc = wave_iscan(inc);
            out[64 * (row0 + k) + lane] = (carry + inc) * LOG2E; carry += __uint_as_float((unsigned)__builtin_amdgcn_readlane((int)__float_as_uint(inc), 63)); } }
}
__device__ __forceinline__ void scans(const Params& P, LAS unsigned char* lds) {
    const float* LOGF = (const float*)(P.ws + WS_LOGF); float* C2T = (float*)(P.ws + WS_C2T); float* C2S = (float*)(P.ws + WS_C2S);
    LAS float* sm = (LAS float*)lds;
    const int tid = threadIdx.x, lane = tid & 63, wave = __builtin_amdgcn_readfirstlane(tid >> 6);
    for (int job = blockIdx.x; job < 32; job += gridDim.x) {
        if (job < 16) {
            const int b = job >> 3, h = job & 7; const float* src = LOGF + (size_t)b * LP * 8 + h;
            float x[17];
            const float t = scan_load<17>(x, 17 * wave, [&](int pos) { return pos < LP ? src[(size_t)pos * 8] : 0.f; }, lane);
            const float tot = wave_sum(t);
            __syncthreads();
            if (lane == 0) sm[wave] = tot;
            __syncthreads();
            float carry = 0.f; for (int w = 0; w < wave; ++w) carry += sm[w];
            scan_store<17>(x, 17 * wave, LPP / 64, carry, C2T + (size_t)(b * 8 + h) * LPP, lane);
        } else {
            const int sb = job - 16, h = wave; const float* s0 = P.cache_logf + (size_t)sb * PAST * 8 + h; const float* s1 = LOGF + (size_t)(NPROW + sb * 16) * 8 + h;
            float x[17];
            (void)scan_load<17>(x, 0, [&](int pos) { return pos < PAST ? s0[(size_t)pos * 8] : (pos < PAST + DSEQ ? s1[(size_t)(pos - PAST) * 8] : 0.f); }, lane);
            scan_store<17>(x, 0, SPP / 64, 0.f, C2S + (size_t)(sb * 8 + h) * SPP, lane);
        }
    }
}

constexpr int KS_STRIDE = 144, VS_STRIDE = 272;
constexpr int B_KS = 0, B_VS = 128 * KS_STRIDE, B_CK = B_VS + 64 * VS_STRIDE, B_SIZE = B_CK + 576, L_FLAG = 2 * B_SIZE;

__device__ __forceinline__ void attn_prompt_unit(const Params& P, LAS unsigned char* lds, int b, int h, int jq) {
    const int tid = threadIdx.x, lane = tid & 63, w = __builtin_amdgcn_readfirstlane(tid >> 6), r32 = lane & 31, hi = lane >> 5;
    const bf16_t* Qb = (const bf16_t*)(P.ws + WS_Q); const bf16_t* Kb = (const bf16_t*)(P.ws + WS_K); const bf16_t* Vt = (const bf16_t*)(P.ws + WS_VT);
    const bf16_t* SZA = (const bf16_t*)(P.ws + WS_SZA); bf16_t* A2 = (bf16_t*)(P.ws + WS_A2);
    const float* c2t = (const float*)(P.ws + WS_C2T) + (size_t)(b * 8 + h) * LPP;
    const unsigned* kmaxp = (const unsigned*)(P.ws + WS_CTL) + CTL_KMAX + (b * 8 + h) * 4;
    const int q0 = NMETA + 256 * jq, qlo = q0 + 32 * w, qpos = qlo + r32;
    const size_t prow_q = (size_t)b * LP + qpos;
    const int T_hi = (q0 + 255) >> 7;
    const bf16_t* ksrc = Kb + ((size_t)b * LP + (tid >> 3)) * 512 + h * 64 + (tid & 7) * 8;
    const bf16_t* vsrc = Vt + (size_t)((b * 8 + h) * 64 + (tid >> 4)) * LPP + (tid & 15) * 8;
    const int kdst = B_KS + (tid >> 3) * KS_STRIDE + (tid & 7) * 16, vdst = B_VS + (tid >> 4) * VS_STRIDE + ((tid & 15) >> 1) * 32 + ((tid & 1) ? 8 : 0);
    LAS unsigned* flg = (LAS unsigned*)(lds + L_FLAG);
    u32x4 kA0, kA1, vA0, vA1, kB0, kB1, vB0, vB1; float cA = 0.f, cB = 0.f;
#define ATT_PREFETCH(T, k0, k1, v0, v1, cc) do { k0 = *(const u32x4*)(ksrc + (size_t)(T) * 128 * 512); k1 = *(const u32x4*)(ksrc + ((size_t)(T) * 128 + 64) * 512); \
        v0 = *(const u32x4*)(vsrc + (T) * 128); v1 = *(const u32x4*)(vsrc + (size_t)32 * LPP + (T) * 128); \
        if (tid < 129) { const int ci = 128 * (T) - 1 + tid; cc = c2t[ci < 0 ? 0 : ci]; } } while (0)
    __syncthreads();
    ATT_PREFETCH(T_hi, kA0, kA1, vA0, vA1, cA);
    if (T_hi >= 1) ATT_PREFETCH(T_hi - 1, kB0, kB1, vB0, vB1, cB);
    bf16x8 qf[4]; float qn2 = 0.f;
#pragma unroll
    for (int j = 0; j < 4; ++j) { qf[j] = *(const bf16x8*)(Qb + prow_q * 512 + h * 64 + 16 * j + 8 * hi);
#pragma unroll
        for (int e = 0; e < 8; ++e) { const float x = bf2f((unsigned short)qf[j][e]); qn2 += x * x; } }
    qn2 = sum_x32(qn2);
    const float qnmax = sqrtf(wave_max(qn2));
    const float c2q = c2t[qpos];
    const float c2qmax = wave_max(c2q);
    float k2 = 0.f;
#pragma unroll
    for (int i = 0; i < 4; ++i) k2 += __uint_as_float(__hip_atomic_load(kmaxp + i, __ATOMIC_RELAXED, __HIP_MEMORY_SCOPE_AGENT));
    const float qk_bound = qnmax * sqrtf(k2) * 1.03f + 1.0f;
    float mref = 0.f, l = 0.f; bool seen = false; f32x16 o0, o1, cq16;
#pragma unroll
    for (int r = 0; r < 16; ++r) { o0[r] = 0.f; o1[r] = 0.f; cq16[r] = c2q; }
    bool active = true;
    auto step = [&](int T, int par, u32x4& k0, u32x4& k1, u32x4& v0, u32x4& v1, float& cc) __attribute__((always_inline)) -> bool {
        LAS unsigned char* buf = lds + par * B_SIZE;
        *(LAS u32x4*)(buf + kdst) = k0; *(LAS u32x4*)(buf + kdst + 64 * KS_STRIDE) = k1;
        *(LAS u32x2*)(buf + vdst) = (u32x2){v0.x, v0.y}; *(LAS u32x2*)(buf + vdst + 16) = (u32x2){v0.z, v0.w};
        *(LAS u32x2*)(buf + vdst + 32 * VS_STRIDE) = (u32x2){v1.x, v1.y}; *(LAS u32x2*)(buf + vdst + 32 * VS_STRIDE + 16) = (u32x2){v1.z, v1.w};
        if (tid < 129) ((LAS float*)(buf + B_CK))[3 + tid] = cc;
        if (lane == 0) flg[par * 8 + w] = active ? 1u : 0u;
        if (T >= 2) ATT_PREFETCH(T - 2, k0, k1, v0, v1, cc);
        __syncthreads();
        unsigned any = 0u;
#pragma unroll
        for (int i = 0; i < 8; ++i) any |= flg[par * 8 + i];
        if (!any) return false;
        const LAS float* ckl = (const LAS float*)(buf + B_CK);
#pragma unroll
        for (int half = 1; half >= 0; --half) {
            const int t = 2 * T + half, kv0 = 64 * t;
            if (active && kv0 <= qlo + 31) {
                const LAS unsigned char* kb = buf + B_KS + half * 64 * KS_STRIDE; const LAS unsigned char* vb = buf + B_VS + half * 128; const LAS float* ck = ckl + half * 64 + 4;
                f32x16 p0, p1;
#pragma unroll
                for (int j = 0; j < 4; ++j) {
                    const bf16x8 a0 = *(const LAS bf16x8*)(kb + r32 * KS_STRIDE + (16 * j + 8 * hi) * 2);
                    const bf16x8 a1 = *(const LAS bf16x8*)(kb + (32 + r32) * KS_STRIDE + (16 * j + 8 * hi) * 2);
                    if (j == 0) { p0 = MFMA32(a0, qf[0], cq16); p1 = MFMA32(a1, qf[0], cq16); } else { p0 = MFMA32(a0, qf[j], p0); p1 = MFMA32(a1, qf[j], p1); }
                }
                const bool diag = (kv0 + 63 > qlo);
                float mx = NEGBIG;
#pragma unroll
                for (int g4 = 0; g4 < 4; ++g4) { const f32x4 c0v = *(const LAS f32x4*)(ck + 8 * g4 + 4 * hi), c1v = *(const LAS f32x4*)(ck + 32 + 8 * g4 + 4 * hi);
#pragma unroll
                    for (int i = 0; i < 4; ++i) { const int r = 4 * g4 + i; p0[r] -= c0v[i]; p1[r] -= c1v[i]; } }
                if (diag) {
                    asm volatile("" ::: "memory");
#pragma unroll
                    for (int r = 0; r < 16; ++r) { const int kr = crow(r, hi); if (kv0 + kr > qpos) p0[r] = NEGBIG; if (kv0 + 32 + kr > qpos) p1[r] = NEGBIG; }
                    asm volatile("" ::: "memory");
                }
#pragma unroll
                for (int r = 0; r < 16; ++r) mx = max3f(mx, p0[r], p1[r]);
                { const auto rr = __builtin_amdgcn_permlane32_swap(__float_as_uint(mx), __float_as_uint(mx), false, false); mx = fmaxf(__uint_as_float(rr[0]), __uint_as_float(rr[1])); }
                const bool real = mx > -1e29f;
                const float delta = seen ? fmaxf(mx, 0.f) : (real ? mx : 0.f);
                if (__builtin_amdgcn_ballot_w64(delta != 0.f) != 0ull) {
                    const float alpha = seen ? __builtin_amdgcn_exp2f(-delta) : 1.0f;
                    mref += delta; const float cq = c2q - mref; l *= alpha;
#pragma unroll
                    for (int r = 0; r < 16; ++r) { p0[r] -= delta; p1[r] -= delta; o0[r] *= alpha; o1[r] *= alpha; cq16[r] = cq; }
                }
                seen = seen || real;
#pragma unroll
                for (int r = 0; r < 16; ++r) { p0[r] = __builtin_amdgcn_exp2f(p0[r]); p1[r] = __builtin_amdgcn_exp2f(p1[r]); l += p0[r] + p1[r]; }
                bf16x8 pb[4];
                pb[0] = pack8(p0[0], p0[1], p0[2], p0[3], p0[4], p0[5], p0[6], p0[7]); pb[1] = pack8(p0[8], p0[9], p0[10], p0[11], p0[12], p0[13], p0[14], p0[15]);
                pb[2] = pack8(p1[0], p1[1], p1[2], p1[3], p1[4], p1[5], p1[6], p1[7]); pb[3] = pack8(p1[8], p1[9], p1[10], p1[11], p1[12], p1[13], p1[14], p1[15]);
#pragma unroll
                for (int j = 0; j < 4; ++j) {
                    const LAS unsigned char* x0 = vb + r32 * VS_STRIDE + j * 32 + hi * 16;
                    const bf16x8 A0 = *(const LAS bf16x8*)x0, A1 = *(const LAS bf16x8*)(x0 + 32 * VS_STRIDE);
                    o0 = MFMA32(A0, pb[j], o0); o1 = MFMA32(A1, pb[j], o1);
                }
            }
            if (active && t > 0) {
                const float bound = qk_bound + (c2qmax - ckl[3 + half * 64]);
                const bool need = !(bound < (seen ? mref : NEGBIG) - 150.0f);
                if (__builtin_amdgcn_ballot_w64(need) == 0ull) active = false;
            }
        }
        return true;
    };
    for (int T = T_hi; T >= 0; T -= 2) {
        if (!step(T, 0, kA0, kA1, vA0, vA1, cA)) break;
        if (T < 1) break;
        if (!step(T - 1, 1, kB0, kB1, vB0, vB1, cB)) break;
    }
#undef ATT_PREFETCH
    const float inv = 1.0f / sum_x32(l);
    const size_t R = (size_t)b * SEQ + (qpos - NMETA);
#pragma unroll
    for (int d0 = 0; d0 < 2; ++d0)
#pragma unroll
        for (int g = 0; g < 4; g += 2) {
            const f32x16& o = d0 == 0 ? o0 : o1;
            float lo[4], up[4];
#pragma unroll
            for (int i = 0; i < 4; ++i) { const auto rr = __builtin_amdgcn_permlane32_swap(__float_as_uint(o[4 * g + i] * inv), __float_as_uint(o[4 * (g + 1) + i] * inv), false, false);
                lo[i] = __uint_as_float(rr[0]); up[i] = __uint_as_float(rr[1]); }
            const int d = 32 * d0 + 8 * (g + hi);
            const u32x4 z = *(const u32x4*)(SZA + prow_q * 512 + h * 64 + d);
            u32x4 ov;
            ov.x = cvtpk(lo[0] * __uint_as_float(z.x << 16), lo[1] * __uint_as_float(z.x & 0xffff0000u)); ov.y = cvtpk(lo[2] * __uint_as_float(z.y << 16), lo[3] * __uint_as_float(z.y & 0xffff0000u));
            ov.z = cvtpk(up[0] * __uint_as_float(z.z << 16), up[1] * __uint_as_float(z.z & 0xffff0000u)); ov.w = cvtpk(up[2] * __uint_as_float(z.w << 16), up[3] * __uint_as_float(z.w & 0xffff0000u));
            *(u32x4*)(A2 + R * DM + h * 64 + d) = ov; }
}

__device__ __forceinline__ void attn_sample_item(const Params& P, LAS unsigned char* lds, int sb, int h) {
    const int tid = threadIdx.x, lane = tid & 63, w = __builtin_amdgcn_readfirstlane(tid >> 6), r32 = lane & 31, hi = lane >> 5;
    const bf16_t* Qb = (const bf16_t*)(P.ws + WS_Q); const bf16_t* SZA = (const bf16_t*)(P.ws + WS_SZA); bf16_t* A2 = (bf16_t*)(P.ws + WS_A2);
    const float* c2s = (const float*)(P.ws + WS_C2S) + (size_t)(sb * 8 + h) * SPP;
    const float* kc = P.cache_k + (size_t)sb * PAST * 512 + h * 64; const float* vc = P.cache_v + (size_t)sb * PAST * 512 + h * 64;
    const float* kn = P.out + O_KS + (size_t)sb * DSEQ * 512 + h * 64; const float* vn = P.out + O_VS + (size_t)sb * DSEQ * 512 + h * 64;
    const int qi = r32 < 15 ? r32 : 15, qpos = PAST + qi;
    const size_t prow_q = (size_t)NPROW + sb * 16 + qi;
    bf16x8 qf[4];
#pragma unroll
    for (int j = 0; j < 4; ++j) qf[j] = *(const bf16x8*)(Qb + prow_q * 512 + h * 64 + 16 * j + 8 * hi);
    const float c2q = c2s[qpos];
    float m = NEGBIG, l = 0.f; f32x16 o0, o1;
#pragma unroll
    for (int r = 0; r < 16; ++r) { o0[r] = 0.f; o1[r] = 0.f; }
    const int ntl = (w == 0) ? 3 : 2;
    for (int ti = 0; ti < ntl; ++ti) {
        const int t = (ntl == 3) ? (ti == 0 ? 16 : (ti == 1 ? 8 : 0)) : (ti == 0 ? w + 8 : w), kv0 = 64 * t;
        auto krow = [&](int kvp) -> const float* { const int p = kvp < PAST + DSEQ ? kvp : PAST + DSEQ - 1; return p < PAST ? kc + (size_t)p * 512 : kn + (size_t)(p - PAST) * 512; };
        auto vrow = [&](int kvp) -> const float* { const int p = kvp < PAST + DSEQ ? kvp : PAST + DSEQ - 1; return p < PAST ? vc + (size_t)p * 512 : vn + (size_t)(p - PAST) * 512; };
        f32x16 p0, p1;
#pragma unroll
        for (int r = 0; r < 16; ++r) { p0[r] = 0.f; p1[r] = 0.f; }
        const float* k0p = krow(kv0 + r32) + 8 * hi; const float* k1p = krow(kv0 + 32 + r32) + 8 * hi;
        f32x4 kx[4][4];
#pragma unroll
        for (int j = 0; j < 4; ++j) { kx[j][0] = *(const f32x4*)(k0p + 16 * j); kx[j][1] = *(const f32x4*)(k0p + 16 * j + 4); kx[j][2] = *(const f32x4*)(k1p + 16 * j); kx[j][3] = *(const f32x4*)(k1p + 16 * j + 4); }
        float vx[4][8], vy[4][8];
#define SMP_LOAD_V() do { _Pragma("unroll") for (int j = 0; j < 4; ++j) _Pragma("unroll") for (int e = 0; e < 8; ++e) { \
            const float* vr = vrow(kv0 + 16 * j + (e & 3) + 8 * (e >> 2) + 4 * hi); vx[j][e] = vr[r32]; vy[j][e] = vr[32 + r32]; } } while (0)
        if (ti == 0) SMP_LOAD_V();
#pragma unroll
        for (int j = 0; j < 4; ++j) {
            const bf16x8 a0 = pack8(kx[j][0][0], kx[j][0][1], kx[j][0][2], kx[j][0][3], kx[j][1][0], kx[j][1][1], kx[j][1][2], kx[j][1][3]), a1 = pack8(kx[j][2][0], kx[j][2][1], kx[j][2][2], kx[j][2][3], kx[j][3][0], kx[j][3][1], kx[j][3][2], kx[j][3][3]);
            p0 = MFMA32(a0, qf[j], p0); p1 = MFMA32(a1, qf[j], p1);
        }
        float mx = NEGBIG;
#pragma unroll
        for (int g4 = 0; g4 < 4; ++g4) { const f32x4 c0v = *(const f32x4*)(c2s + kv0 + 8 * g4 + 4 * hi), c1v = *(const f32x4*)(c2s + kv0 + 32 + 8 * g4 + 4 * hi);
#pragma unroll
            for (int i = 0; i < 4; ++i) { const int r = 4 * g4 + i, kr = 8 * g4 + 4 * hi + i;
                float s0 = p0[r] + (c2q - c0v[i]), s1 = p1[r] + (c2q - c1v[i]);
                if (kv0 + kr > qpos) s0 = NEGBIG; if (kv0 + 32 + kr > qpos) s1 = NEGBIG;
                p0[r] = s0; p1[r] = s1; mx = fmaxf(mx, fmaxf(s0, s1)); } }
        mx = max_x32(mx);
        if (ti > 0) {
            if (__builtin_amdgcn_ballot_w64(!(mx < m - 150.0f)) == 0ull) continue;
            SMP_LOAD_V();
        }
        const float mn = fmaxf(m, mx), alpha = __builtin_amdgcn_exp2f(m - mn);
        float rs = 0.f;
#pragma unroll
        for (int r = 0; r < 16; ++r) { p0[r] = __builtin_amdgcn_exp2f(p0[r] - mn); p1[r] = __builtin_amdgcn_exp2f(p1[r] - mn); rs += p0[r] + p1[r]; }
        l = l * alpha + rs; m = mn;
#pragma unroll
        for (int r = 0; r < 16; ++r) { o0[r] *= alpha; o1[r] *= alpha; }
        bf16x8 pb[4];
        pb[0] = pack8(p0[0], p0[1], p0[2], p0[3], p0[4], p0[5], p0[6], p0[7]); pb[1] = pack8(p0[8], p0[9], p0[10], p0[11], p0[12], p0[13], p0[14], p0[15]);
        pb[2] = pack8(p1[0], p1[1], p1[2], p1[3], p1[4], p1[5], p1[6], p1[7]); pb[3] = pack8(p1[8], p1[9], p1[10], p1[11], p1[12], p1[13], p1[14], p1[15]);
#pragma unroll
        for (int j = 0; j < 4; ++j) {
            const bf16x8 A0 = pack8(vx[j][0], vx[j][1], vx[j][2], vx[j][3], vx[j][4], vx[j][5], vx[j][6], vx[j][7]), A1 = pack8(vy[j][0], vy[j][1], vy[j][2], vy[j][3], vy[j][4], vy[j][5], vy[j][6], vy[j][7]);
            o0 = MFMA32(A0, pb[j], o0); o1 = MFMA32(A1, pb[j], o1);
        }
    }
#undef SMP_LOAD_V
    LAS float* ow = (LAS float*)(lds + w * 8448); LAS float* mw = ow + 2048; LAS float* lw = mw + 32;
    const float lt = sum_x32(l);
#pragma unroll
    for (int r = 0; r < 16; ++r) { ow[crow(r, hi) * 32 + r32] = o0[r]; ow[(32 + crow(r, hi)) * 32 + r32] = o1[r]; }
    if (hi == 0) { mw[r32] = m; lw[r32] = lt; }
    __syncthreads();
    {
        const int q = tid & 15, dg = tid >> 4;
        float M = NEGBIG;
#pragma unroll
        for (int i = 0; i < 8; ++i) M = fmaxf(M, ((LAS float*)(lds + i * 8448))[2048 + q]);
        float den = 0.f, n0 = 0.f, n1 = 0.f;
#pragma unroll
        for (int i = 0; i < 8; ++i) { LAS float* oi = (LAS float*)(lds + i * 8448); const float f = __builtin_amdgcn_exp2f(oi[2048 + q] - M);
            den += f * oi[2080 + q]; n0 += f * oi[(2 * dg) * 32 + q]; n1 += f * oi[(2 * dg + 1) * 32 + q]; }
        const size_t pr = (size_t)NPROW + sb * 16 + q;
        const unsigned z = *(const unsigned*)(SZA + pr * 512 + h * 64 + 2 * dg);
        const float inv = 1.0f / den;
        *(unsigned*)(A2 + (size_t)(MG + sb * 16 + q) * DM + h * 64 + 2 * dg) = cvtpk(n0 * inv * __uint_as_float(z << 16), n1 * inv * __uint_as_float(z & 0xffff0000u));
    }
    __syncthreads();
}

__device__ __forceinline__ void unpack8(const u32x4 a, float (&u)[8]) {
#pragma unroll
    for (int e = 0; e < 4; ++e) { u[2 * e] = __uint_as_float(a[e] << 16); u[2 * e + 1] = __uint_as_float(a[e] & 0xffff0000u); } }
__device__ __forceinline__ void conv_chunks(const Params& P, int gw, int ngw) {
    const int lane = threadIdx.x & 63, c = 8 * lane;
    const bf16_t* U = (const bf16_t*)(P.ws + WS_U); const bf16_t* Gg = (const bf16_t*)(P.ws + WS_G); bf16_t* A2 = (bf16_t*)(P.ws + WS_A2);
    float w0[8], w1[8], w2[8];
#pragma unroll
    for (int e = 0; e < 8; ++e) { w0[e] = P.conv_w[c + e]; w1[e] = P.conv_w[512 + c + e]; w2[e] = P.conv_w[1024 + c + e]; }
    for (int ch = gw; ch < MOUT / 16; ch += ngw) {
        const int R0 = 16 * ch; int prow0; float um2[8], um1[8];
        if (ch < MG / 16) { const int b = R0 >> 13; prow0 = b * LP + NMETA + (R0 & (SEQ - 1));
            unpack8(*(const u32x4*)(U + (size_t)(prow0 - 2) * 512 + c), um2); unpack8(*(const u32x4*)(U + (size_t)(prow0 - 1) * 512 + c), um1); }
        else { const int sb = ch - MG / 16; prow0 = NPROW + 16 * sb; const float* st = P.state_conv + (size_t)sb * 2 * 512 + c;
#pragma unroll
            for (int e = 0; e < 8; ++e) { um2[e] = st[e]; um1[e] = st[512 + e]; } }
        u32x4 uq[16], gq[16];
#pragma unroll
        for (int i = 0; i < 16; ++i) { uq[i] = *(const u32x4*)(U + (size_t)(prow0 + i) * 512 + c); gq[i] = *(const u32x4*)(Gg + (size_t)(prow0 + i) * 512 + c); }
#pragma unroll
        for (int i = 0; i < 16; ++i) { float u0[8], g0[8]; unpack8(uq[i], u0); unpack8(gq[i], g0);
            u32x4 o;
#pragma unroll
            for (int e = 0; e < 4; ++e) { const float y0 = w0[2 * e] * um2[2 * e] + w1[2 * e] * um1[2 * e] + w2[2 * e] * u0[2 * e], y1 = w0[2 * e + 1] * um2[2 * e + 1] + w1[2 * e + 1] * um1[2 * e + 1] + w2[2 * e + 1] * u0[2 * e + 1];
                o[e] = cvtpk(g0[2 * e] * y0, g0[2 * e + 1] * y1); }
            *(u32x4*)(A2 + (size_t)(R0 + i) * DM + 512 + c) = o;
#pragma unroll
            for (int e = 0; e < 8; ++e) { um2[e] = um1[e]; um1[e] = u0[e]; } }
    }
}

__device__ __forceinline__ void phase2_mem(const Params& P, LAS unsigned char* lds) {
    const int G = gridDim.x, blk = blockIdx.x, wave = __builtin_amdgcn_readfirstlane(threadIdx.x >> 6);
    const int ncb = G >= 2 ? G / 2 : 1;
    __syncthreads();
#pragma unroll 1
    for (int s = G - 1 - blk; s < 128; s += G) attn_sample_item(P, lds, s >> 3, s & 7);
    if (blk < ncb) {
        { LAS float* scr = (LAS float*)(lds + wave * 8448); bf16_t* WoutT = (bf16_t*)(P.ws + WS_WOUT); const int lane = threadIdx.x & 63;
          for (int r = blk * 8 + wave; r < 512; r += ncb * 8) { const int kb = r >> 5, nb = r & 31; transpose_item(P.w_out, DM, nb * 32, WoutT, nb * 32, kb * 64, scr, lane); } }
        conv_chunks(P, blk * 8 + wave, ncb * 8);
    }
    __syncthreads();
}
__device__ __forceinline__ void phase2(const Params& P, LAS unsigned char* lds, const XcdBarrier& bar) {
    const int G = gridDim.x, blk = blockIdx.x;
    const bool first = ((blk >> 3) & 1) != 0;
    if (first) phase2_mem(P, lds);
#pragma unroll 1
    for (int u = blk; u < 512; u += G) attn_prompt_unit(P, lds, (u >> 3) & 1, u & 7, u >> 4);
    if (!first) phase2_mem(P, lds);
    __syncthreads();
}

__device__ __forceinline__ void mini_outproj(const Params& P) {
    const int tid = threadIdx.x, lane = tid & 63, wave = __builtin_amdgcn_readfirstlane(tid >> 6), fr = lane & 15, fq = lane >> 4;
    const bf16_t* WoutT = (const bf16_t*)(P.ws + WS_WOUT); const bf16_t* A2 = (const bf16_t*)(P.ws + WS_A2); float* ssqs = (float*)(P.ws + WS_SSQS);
    for (int wi = blockIdx.x * 8 + wave; wi < 512; wi += gridDim.x * 8) {
        const int rf = wi & 15, p = wi >> 4, c0 = 32 * p;
        f32x4 a0, a1;
        mini_mma(A2 + (size_t)(MG + 16 * rf) * DM, WoutT + (size_t)c0 * DM, WoutT + (size_t)(c0 + 16) * DM, lane, a0, a1);
        const int rs = 16 * rf + fr; const size_t off = (size_t)rs * DM + c0 + 4 * fq;
        const f32x4 v0 = *(const f32x4*)(P.x_sample + off) + a0, v1 = *(const f32x4*)(P.x_sample + off + 16) + a1;
        *(f32x4*)(P.out + O_YS + off) = v0; *(f32x4*)(P.out + O_YS + off + 16) = v1;
        float s = (v0[0] * v0[0] + v0[1] * v0[1]) + (v0[2] * v0[2] + v0[3] * v0[3]) + (v1[0] * v1[0] + v1[1] * v1[1]) + (v1[2] * v1[2] + v1[3] * v1[3]);
        s = sum_x32(sum_x16(s));
        if (fq == 0) ssqs[rs * 32 + p] = s;
    }
}
constexpr int LDS_STASH = 131072;
__device__ __forceinline__ void mini_out_begin(const Params& P, LAS unsigned char* lds) {
    const int tid = threadIdx.x, lane = tid & 63, wave = __builtin_amdgcn_readfirstlane(tid >> 6), fr = lane & 15, fq = lane >> 4, blk = blockIdx.x;
    if (blk >= 64) return;
    const bf16_t* WoutT = (const bf16_t*)(P.ws + WS_WOUT); const bf16_t* A2 = (const bf16_t*)(P.ws + WS_A2);
    unsigned* xs = (unsigned*)(P.ws + WS_SSQS); unsigned* cnt = (unsigned*)(P.ws + WS_CTL) + CW_SEAM2;
    const int p = blk >> 1, rf = 8 * (blk & 1) + wave, c0 = 32 * p;
    const int rs = 16 * rf + fr; const size_t off = (size_t)rs * DM + c0 + 4 * fq;
    const f32x4 xs0 = *(const f32x4*)(P.x_sample + off), xs1 = *(const f32x4*)(P.x_sample + off + 16);
    bf16x8 af[16];
    mini_load_a(A2 + (size_t)(MG + 16 * rf) * DM, lane, 0, af);
    mini_stage_w(lds, WoutT, c0, c0 + 16);
    __syncthreads();
    f32x4 a0 = (f32x4){0.f, 0.f, 0.f, 0.f}, a1 = a0;
    mini_mma_lds(lds, af, lane, 0, a0, a1);
    asm volatile("" ::: "memory");
    mini_load_a(A2 + (size_t)(MG + 16 * rf) * DM, lane, 1, af);
    mini_mma_lds(lds, af, lane, 1, a0, a1);
    const f32x4 v0 = xs0 + a0, v1 = xs1 + a1;
    float s = (v0[0] * v0[0] + v0[1] * v0[1]) + (v0[2] * v0[2] + v0[3] * v0[3]) + (v1[0] * v1[0] + v1[1] * v1[1]) + (v1[2] * v1[2] + v1[3] * v1[3]);
    s = sum_x32(sum_x16(s));
    if (fq == 0) __hip_atomic_store(xs + (size_t)rs * 32 + p, __float_as_uint(s), __ATOMIC_RELAXED, __HIP_MEMORY_SCOPE_AGENT);
    asm volatile("s_waitcnt vmcnt(0)" ::: "memory");
    if (lane == 0) __hip_atomic_fetch_add(cnt + 64 * rf, 1u, __ATOMIC_RELAXED, __HIP_MEMORY_SCOPE_AGENT);
    LAS f32x4* st = (LAS f32x4*)(lds + LDS_STASH + wave * 2048 + lane * 32);
    st[0] = v0; st[1] = v1;
}
__device__ __forceinline__ void mini_out_finish(const Params& P, LAS unsigned char* lds) {
    const int tid = threadIdx.x, lane = tid & 63, wave = __builtin_amdgcn_readfirstlane(tid >> 6), fr = lane & 15, fq = lane >> 4, blk = blockIdx.x;
    if (blk >= 64) return;
    const unsigned* xs = (const unsigned*)(P.ws + WS_SSQS); unsigned* cnt = (unsigned*)(P.ws + WS_CTL) + CW_SEAM2;
    const int p = blk >> 1, rf = 8 * (blk & 1) + wave, c0 = 32 * p;
    const int rs = 16 * rf + fr; const size_t off = (size_t)rs * DM + c0 + 4 * fq;
    const f32x4 g0 = *(const f32x4*)(P.final_g + c0 + 4 * fq), g1 = *(const f32x4*)(P.final_g + c0 + 16 + 4 * fq);
    { unsigned sp = 0;
      while ((unsigned)__builtin_amdgcn_readfirstlane(__hip_atomic_load(cnt + 64 * rf, __ATOMIC_RELAXED, __HIP_MEMORY_SCOPE_AGENT)) < 32u) { __builtin_amdgcn_s_sleep(2); if (++sp > (1u << 22)) break; }
      __builtin_amdgcn_fence(__ATOMIC_ACQUIRE, "agent"); }
    float t = 0.f;
#pragma unroll
    for (int k = 0; k < 8; ++k) t += __uint_as_float(__hip_atomic_load(xs + (size_t)rs * 32 + 8 * fq + k, __ATOMIC_RELAXED, __HIP_MEMORY_SCOPE_AGENT));
    t = sum_x32(sum_x16(t));
    const float rstd = 1.0f / sqrtf(t * (1.0f / DM) + EPS);
    const LAS f32x4* st = (const LAS f32x4*)(lds + LDS_STASH + wave * 2048 + lane * 32);
    const f32x4 v0 = st[0], v1 = st[1];
    *(f32x4*)(P.out + O_YS + off) = v0 * rstd * g0; *(f32x4*)(P.out + O_YS + off + 16) = v1 * rstd * g1;
}
__device__ __forceinline__ void phase4(const Params& P) {
    const int tid = threadIdx.x, lane = tid & 63, wave = __builtin_amdgcn_readfirstlane(tid >> 6);
    const float* ssq = (const float*)(P.ws + WS_SSQ); const float* ssqs = (const float*)(P.ws + WS_SSQS);
    f32x4 gv[4];
#pragma unroll
    for (int j = 0; j < 4; ++j) gv[j] = ((const f32x4*)P.final_g)[lane + 64 * j];
    for (int R = blockIdx.x * 8 + wave; R < MOUT; R += gridDim.x * 8) {
        float* y; float part;
        if (R < MG) { y = P.out + O_YP + (size_t)R * DM; part = lane < 16 ? ssq[(size_t)R * 16 + lane] : 0.f; }
        else { y = P.out + O_YS + (size_t)(R - MG) * DM; part = lane < 32 ? ssqs[(R - MG) * 32 + lane] : 0.f; }
        const float ss = wave_sum(part);
        const float rstd = 1.0f / sqrtf(ss * (1.0f / DM) + EPS);
#pragma unroll
        for (int j = 0; j < 4; ++j) { f32x4 v = ((f32x4*)y)[lane + 64 * j]; v = v * rstd * gv[j]; ((f32x4*)y)[lane + 64 * j] = v; }
    }
}

constexpr int LDS_BYTES = 149504;
__global__ void __launch_bounds__(512, 2) hymba_fwd(Params P) {
    extern __shared__ __attribute__((aligned(16))) unsigned char lds_raw[];
    LAS unsigned char* lds = (LAS unsigned char*)lds_raw;
    cg::grid_group grid = cg::this_grid();
    const int lo = P.ph_lo, hi = P.ph_hi;
    if (lo < 0) grid.sync();
    volatile LAS unsigned* bst = (volatile LAS unsigned*)(lds + LDS_BYTES - 64);
    if (threadIdx.x < 2) bst[threadIdx.x] = 0u;
    __syncthreads();
    XcdBarrier bar; bar.bar = (unsigned*)(P.ws + WS_CTL) + CW_BAR; bar.x = 0; bar.st = bst;
    if (hi - lo > 1) bar = xcd_barrier_post((unsigned*)(P.ws + WS_CTL) + CW_BAR, bst);
#define IN(k) (lo <= (k) && (k) < hi)
#define SEAM(k) do { if (IN(k) && IN((k) + 1)) xcd_barrier(bar); } while (0)
    Sink S{P.out, (bf16_t*)(P.ws + WS_Q), (bf16_t*)(P.ws + WS_K), (bf16_t*)(P.ws + WS_VT), (bf16_t*)(P.ws + WS_SZA), (bf16_t*)(P.ws + WS_U), (bf16_t*)(P.ws + WS_G)};
    unsigned* kmax = (unsigned*)(P.ws + WS_CTL) + CTL_KMAX;
    if (IN(0)) { phase0(P, lds); }
    SEAM(0);
    if (IN(1)) {
        __syncthreads();
        pg8::Gemm g{(const pg8::bf16_t*)(P.ws + WS_H), (const pg8::bf16_t*)(P.ws + WS_WIN), MG, 4096, DM}; pg8::StaticOrder O; O.init(MG, 4096, gridDim.x, (int)blockIdx.x);
        pg8::EpiIn E{S, kmax};
        pg8::gemm_phase<pg8::EpiIn, pg8::StaticOrder, true, true>(lds, g, O, E);
        mini_inproj(P, S, kmax, lds);
        __syncthreads();
        scans(P, lds);
    }
    SEAM(1);
    if (IN(2)) { phase2(P, lds, bar); }
    SEAM(2);
    const bool fusedn = (gridDim.x == 256);
    if (IN(3)) {
        __syncthreads();
        pg8::Gemm g{(const pg8::bf16_t*)(P.ws + WS_A2), (const pg8::bf16_t*)(P.ws + WS_WOUT), MG, DM, DM}; pg8::StaticOrder O; O.init(MG, DM, gridDim.x, (int)blockIdx.x);
        if (fusedn) {
            pg8::EpiOutNorm E{P.x_prompt, P.out + O_YP, P.final_g, (unsigned*)(P.ws + WS_SSQ), (unsigned*)(P.ws + WS_CTL) + CW_SEAM, &P};
            pg8::gemm_phase<pg8::EpiOutNorm, pg8::StaticOrder, false, true>(lds, g, O, E);
            mini_out_finish(P, lds);
        } else {
            pg8::EpiOut E{P.x_prompt, P.out + O_YP, (float*)(P.ws + WS_SSQ)};
            pg8::gemm_phase<pg8::EpiOut, pg8::StaticOrder, true, true>(lds, g, O, E);
            mini_outproj(P);
        }
    }
    if (!fusedn) {
        SEAM(3);
        if (IN(4)) { phase4(P); }
    }
#undef IN
#undef SEAM
}

extern "C" void kernel_launch(void* const* d_in, const int* in_sizes, int n_in, void* d_out, int out_size, void* d_ws, size_t ws_size, hipStream_t stream) {
    static int grid = 0;
    if (grid == 0) {
        if (n_in != 13 || out_size != 34263296 || ws_size < WS_END) { fprintf(stderr, "kernel_launch: unexpected problem shape (n_in %d, out %d, ws %zu)\n", n_in, out_size, ws_size); grid = -1; return; }
        int dev = 0, cus = 0, per_cu = 0;
        hipGetDevice(&dev); hipDeviceGetAttribute(&cus, hipDeviceAttributeMultiprocessorCount, dev);
        hipFuncSetAttribute((const void*)hymba_fwd, hipFuncAttributeMaxDynamicSharedMemorySize, LDS_BYTES);
        hipOccupancyMaxActiveBlocksPerMultiprocessor(&per_cu, (const void*)hymba_fwd, 512, LDS_BYTES);
        if (per_cu < 1) { fprintf(stderr, "kernel_launch: occupancy query reports %d blocks per CU\n", per_cu); per_cu = 1; }
        grid = cus * 1;
        if (grid > 256) grid = 256;
    }
    if (grid < 0) return;
    if (hipMemsetAsync(d_ws, 0, CTL_ZERO_BYTES, stream) != hipSuccess) { fprintf(stderr, "kernel_launch: memset failed\n"); return; }
    Params p{};
    p.x_prompt = (const float*)d_in[0]; p.x_sample = (const float*)d_in[1]; p.cache_k = (const float*)d_in[2]; p.cache_v = (const float*)d_in[3]; p.cache_logf = (const float*)d_in[4];
    p.state_conv = (const float*)d_in[5]; p.meta = (const float*)d_in[6]; p.norm_g = (const float*)d_in[7]; p.w_in = (const float*)d_in[8]; p.b_f = (const float*)d_in[9];
    p.conv_w = (const float*)d_in[10]; p.w_out = (const float*)d_in[11]; p.final_g = (const float*)d_in[12];
    p.out = (float*)d_out; p.ws = (unsigned char*)d_ws;
#if MK_N_LAUNCHES == 1
    p.ph_lo = 0; p.ph_hi = 5;
    void* args[] = {&p};
    hipError_t e = hipLaunchCooperativeKernel((const void*)hymba_fwd, dim3(grid), dim3(512), args, LDS_BYTES, stream);
    if (e != hipSuccess) fprintf(stderr, "cooperative launch failed: %s (grid %d)\n", hipGetErrorString(e), grid);
#else
    for (int ph = 0; ph < 5; ++ph) { p.ph_lo = ph; p.ph_hi = ph + 1; hipLaunchKernelGGL(hymba_fwd, dim3(grid), dim3(512), LDS_BYTES, stream, p); }
#endif
}
```

```cpp
#include <hip/hip_runtime.h>
#include <hip/hip_cooperative_groups.h>
#include <cstdio>
#include <cstdint>
namespace cg = cooperative_groups;
namespace pg8 {
#define PG8_LAS __attribute__((address_space(3)))
typedef unsigned short bf16_t;
typedef short bf16x8 __attribute__((ext_vector_type(8)));
typedef float f32x4 __attribute__((ext_vector_type(4)));
typedef unsigned u32x4 __attribute__((ext_vector_type(4)));
constexpr int BM = 256, BK = 64, HALF = 128, HTB = HALF * BK * 2  , STAGE_BYTES = 8 * HTB, NXCD = 8, WGM = 8;

__host__ __device__ __forceinline__ int lds_byte(int r, int c) { const int st = (r >> 4) * 2 + (c >> 5), rr = r & 15, cc = c & 31, ob = rr * 64 + cc * 2; return st * 1024 + (ob ^ (((ob >> 9) & 1) << 5)); }
__host__ __device__ __forceinline__ void stage_rc(int b, int& R, int& C) { const int st = b / 1024, sb = b % 1024, swz = sb ^ (((sb >> 9) & 1) << 5); R = (st >> 1) * 16 + swz / 64; C = (st & 1) * 32 + (swz % 64) / 2; }
__host__ __device__ __forceinline__ int perm32(int rho) { const int n = rho >> 4, i = rho & 15; return 8 * (i >> 2) + 4 * n + (i & 3); }

struct Unit { int pm, pn; };
struct Gemm { const bf16_t* A; const bf16_t* Bt; int M, N, K; };

struct StaticOrder {
    int nM, nN, nwg, G, c, nr, mult;
    __host__ __device__ void init(int M, int N, int G_, int c_, int mult_ = 1) { nM = M / BM; nN = N / BM; nwg = nM * nN; G = G_; c = c_; nr = c < nwg ? (nwg - c + G - 1) / G : 0; mult = mult_; }
    __host__ __device__ bool next(int i, Unit& u) const {
        if (i >= nr * mult) return false;
        const long L = (long)(i % nr) * G + c;
        int wgid = (int)L; { const int q = nwg / NXCD, r = nwg % NXCD, xcd = wgid % NXCD, off = wgid / NXCD; wgid = (xcd < r ? xcd * (q + 1) : r * (q + 1) + (xcd - r) * q) + off; }
        const int nig = WGM * nN, gid = wgid / nig, fm = gid * WGM, gsz = (nM - fm) < WGM ? (nM - fm) : WGM;
        u.pm = fm + ((wgid % nig) % gsz); u.pn = (wgid % nig) / gsz; return true;
    }
    __device__ __forceinline__ void a_ready(const Unit&) const {}
    __device__ __forceinline__ void done(const Unit&) const {}
};

template <class Epi, class Sched, bool ALIGN_EPI = false, bool SP2 = false>
__device__ __forceinline__ void gemm_phase(PG8_LAS unsigned char* lds, const Gemm g, const Sched& S, const Epi& E) {
    const int tid = threadIdx.x, wid = __builtin_amdgcn_readfirstlane(tid >> 6), lane = tid & 63, wr = wid >> 2, wc = wid & 3, fr = lane & 15, fq = lane >> 4;
    const int K = g.K, nt = K / BK;
    unsigned voffA[2], voffB[2];
#pragma unroll
    for (int i = 0; i < 2; ++i) { int R, C; stage_rc(tid * 16 + i * 8192, R, C); const int Rb = Epi::PERM ? ((R & ~31) + perm32(R & 31)) : R;
        voffA[i] = (unsigned)(R * K + C) * 2u; voffB[i] = (unsigned)(Rb * K + C) * 2u; }
    const size_t kstep = (size_t)(BK * 2);
    const size_t hstep = (size_t)HALF * K * 2;
    const size_t tstep = 2 * hstep;
    const unsigned ldsw = (unsigned)wid * 1024u;
    const int aoff = lds_byte(wr * 64 + fr, fq * 8), boff = lds_byte(wc * 32 + fr, fq * 8);
#define PG8_SA(b, h) (((b) * 2 + (h)) * HTB)
#define PG8_SB(b, h) ((4 + (b) * 2 + (h)) * HTB)
#define PG8_STAGE(bufoff, gbase, voff) do { _Pragma("unroll") for (int _i = 0; _i < 2; ++_i) \
        __builtin_amdgcn_global_load_lds((const unsigned*)((const char*)(gbase) + (voff)[_i]), (PG8_LAS unsigned*)(lds + (bufoff) + ldsw + _i * 8192), 16, 0, 0); } while (0)
#define PG8_LDA(dst, b, h) do { _Pragma("unroll") for (int m = 0; m < 4; ++m) _Pragma("unroll") for (int k = 0; k < 2; ++k) dst[m][k] = *(const PG8_LAS bf16x8*)(lds + PG8_SA(b, h) + aoff + m * 2048 + k * 1024); } while (0)
#define PG8_LDB(dst, b, h) do { _Pragma("unroll") for (int n = 0; n < 2; ++n) _Pragma("unroll") for (int k = 0; k < 2; ++k) dst[n][k] = *(const PG8_LAS bf16x8*)(lds + PG8_SB(b, h) + boff + n * 2048 + k * 1024); } while (0)
#define PG8_MMA(ai, bj, At, Bt) do { __builtin_amdgcn_s_setprio(1); _Pragma("unroll") for (int m = 0; m < 4; ++m) _Pragma("unroll") for (int n = 0; n < 2; ++n) _Pragma("unroll") for (int k = 0; k < 2; ++k) \
        acc[ai][bj][m][n] = __builtin_amdgcn_mfma_f32_16x16x32_bf16(Bt[n][k], At[m][k], acc[ai][bj][m][n], 0, 0, 0); __builtin_amdgcn_s_setprio(0); } while (0)
#define PG8_WAIT_V(n) asm volatile("s_waitcnt vmcnt(" #n ")" ::: "memory")
#define PG8_WAIT_L(n) asm volatile("s_waitcnt lgkmcnt(" #n ")" ::: "memory")
#define PG8_BAR __builtin_amdgcn_s_barrier()
#define PG8_SCHED __builtin_amdgcn_sched_barrier(0)
    Unit cur, nxt; int ui = 0;
    if (!S.next(0, cur)) return;
    f32x4 acc[2][2][4][2];
    if constexpr (Epi::INIT_ACC) { E.init_acc(acc, cur, wr, wc, fr, fq); E.after_init(lds); } else {
#pragma unroll
    for (int a = 0; a < 2; ++a)
#pragma unroll
        for (int b = 0; b < 2; ++b)
#pragma unroll
            for (int m = 0; m < 4; ++m)
#pragma unroll
                for (int n = 0; n < 2; ++n) acc[a][b][m][n] = (f32x4){0.f, 0.f, 0.f, 0.f};
    }
    bf16x8 At[4][2], B0[2][2], B1[2][2];
    const char* cA = (const char*)g.A + (size_t)cur.pm * tstep; const char* cB = (const char*)g.Bt + (size_t)cur.pn * tstep;
    S.a_ready(cur);
    if constexpr (SP2) {
        PG8_STAGE(PG8_SB(0, 0), cB, voffB); PG8_STAGE(PG8_SB(0, 1), cB + hstep, voffB); PG8_STAGE(PG8_SA(0, 0), cA, voffA); PG8_STAGE(PG8_SA(0, 1), cA + hstep, voffA);
        if (wr == 1) PG8_BAR;
        PG8_WAIT_V(2); PG8_BAR;
        PG8_STAGE(PG8_SB(1, 0), cB + kstep, voffB); PG8_STAGE(PG8_SA(1, 0), cA + kstep, voffA); PG8_STAGE(PG8_SB(1, 1), cB + hstep + kstep, voffB);
        PG8_WAIT_V(6); PG8_BAR;
    } else {
        PG8_STAGE(PG8_SB(0, 0), cB, voffB); PG8_STAGE(PG8_SA(0, 0), cA, voffA); PG8_STAGE(PG8_SB(0, 1), cB + hstep, voffB); PG8_STAGE(PG8_SA(0, 1), cA + hstep, voffA);
        if (wr == 1) PG8_BAR;
        PG8_WAIT_V(4); PG8_BAR;
        PG8_STAGE(PG8_SB(1, 0), cB + kstep, voffB); PG8_STAGE(PG8_SA(1, 0), cA + kstep, voffA); PG8_STAGE(PG8_SB(1, 1), cB + hstep + kstep, voffB);
        PG8_WAIT_V(6); PG8_BAR;
    }
    for (;;) {
        const bool has_next = S.next(ui + 1, nxt);
        const char* nA = has_next ? (const char*)g.A + (size_t)nxt.pm * tstep : cA; const char* nB = has_next ? (const char*)g.Bt + (size_t)nxt.pn * tstep : cB;
        for (int t = 0; t < nt; t += 2) {
            const bool last = (t == nt - 2);
            const char* a1 = cA + (size_t)(t + 1) * kstep;
            const char* a2 = last ? nA : cA + (size_t)(t + 2) * kstep; const char* b2 = last ? nB : cB + (size_t)(t + 2) * kstep;
            const char* a3 = a2 + kstep; const char* b3 = b2 + kstep;
            if (last && has_next) S.a_ready(nxt);
            if constexpr (SP2) {
            PG8_LDB(B0, 0, 0); PG8_LDB(B1, 0, 1); PG8_SCHED; PG8_LDA(At, 0, 0); PG8_STAGE(PG8_SA(1, 1), a1 + hstep, voffA);
            PG8_WAIT_V(8); PG8_WAIT_L(0); PG8_BAR; PG8_MMA(0, 0, At, B0); PG8_MMA(0, 1, At, B1); PG8_BAR; PG8_SCHED;
            PG8_LDA(At, 0, 1); PG8_STAGE(PG8_SB(0, 0), b2, voffB); PG8_STAGE(PG8_SB(0, 1), b2 + hstep, voffB); PG8_STAGE(PG8_SA(0, 0), a2, voffA);
            PG8_WAIT_V(8); PG8_WAIT_L(0); PG8_BAR; PG8_MMA(1, 0, At, B0); PG8_MMA(1, 1, At, B1); PG8_BAR; PG8_SCHED;
            PG8_LDB(B0, 1, 0); PG8_LDB(B1, 1, 1); PG8_SCHED; PG8_LDA(At, 1, 0); PG8_STAGE(PG8_SA(0, 1), a2 + hstep, voffA);
            PG8_WAIT_V(8); PG8_WAIT_L(0); PG8_BAR; PG8_MMA(0, 0, At, B0); PG8_MMA(0, 1, At, B1); PG8_BAR; PG8_SCHED;
            PG8_LDA(At, 1, 1); PG8_STAGE(PG8_SB(1, 0), b3, voffB); PG8_STAGE(PG8_SB(1, 1), b3 + hstep, voffB); PG8_STAGE(PG8_SA(1, 0), a3, voffA);
            PG8_WAIT_V(8); PG8_WAIT_L(0); PG8_BAR; PG8_MMA(1, 0, At, B0); PG8_MMA(1, 1, At, B1); PG8_BAR; PG8_SCHED;
            } else {
            PG8_LDB(B0, 0, 0); PG8_SCHED; PG8_LDA(At, 0, 0); PG8_STAGE(PG8_SA(1, 1), a1 + hstep, voffA);
            PG8_WAIT_L(8); PG8_BAR; PG8_WAIT_L(0); PG8_MMA(0, 0, At, B0); PG8_BAR; PG8_SCHED;
            PG8_LDB(B1, 0, 1); PG8_STAGE(PG8_SB(0, 0), b2, voffB);
            PG8_BAR; PG8_WAIT_L(0); PG8_MMA(0, 1, At, B1); PG8_BAR;
            PG8_LDA(At, 0, 1); PG8_STAGE(PG8_SA(0, 0), a2, voffA);
            PG8_BAR; PG8_WAIT_L(0); PG8_MMA(1, 0, At, B0); PG8_BAR; PG8_SCHED;
            PG8_STAGE(PG8_SB(0, 1), b2 + hstep, voffB);
            PG8_WAIT_V(6); PG8_BAR; PG8_MMA(1, 1, At, B1); PG8_BAR;
            PG8_LDB(B0, 1, 0); PG8_SCHED; PG8_LDA(At, 1, 0); PG8_STAGE(PG8_SA(0, 1), a2 + hstep, voffA);
            PG8_WAIT_L(8); PG8_BAR; PG8_WAIT_L(0); PG8_MMA(0, 0, At, B0); PG8_BAR; PG8_SCHED;
            PG8_LDB(B1, 1, 1); PG8_STAGE(PG8_SB(1, 0), b3, voffB);
            PG8_BAR; PG8_WAIT_L(0); PG8_MMA(0, 1, At, B1); PG8_BAR;
            PG8_LDA(At, 1, 1); PG8_STAGE(PG8_SA(1, 0), a3, voffA);
            PG8_BAR; PG8_WAIT_L(0); PG8_MMA(1, 0, At, B0); PG8_BAR; PG8_SCHED;
            PG8_STAGE(PG8_SB(1, 1), b3 + hstep, voffB);
            PG8_WAIT_V(6); PG8_BAR; PG8_MMA(1, 1, At, B1); PG8_BAR;
            }
        }
        if constexpr (ALIGN_EPI) { if (wr == 0) PG8_BAR; }
        if constexpr (!Epi::AFTER_DRAIN) { E(acc, cur, wr, wc, fr, fq); S.done(cur); }
        if (!has_next) break;
#pragma unroll
        for (int a = 0; a < 2; ++a)
#pragma unroll
            for (int b = 0; b < 2; ++b)
#pragma unroll
                for (int m = 0; m < 4; ++m)
#pragma unroll
                    for (int n = 0; n < 2; ++n) acc[a][b][m][n] = (f32x4){0.f, 0.f, 0.f, 0.f};
        cur = nxt; cA = nA; cB = nB; ++ui;
        if constexpr (ALIGN_EPI) { if (wr == 1) PG8_BAR; }
    }
    PG8_WAIT_V(0);
    if constexpr (!ALIGN_EPI) { if (wr == 0) PG8_BAR; }
    PG8_BAR;
    if constexpr (Epi::AFTER_DRAIN) { E.fused(acc, cur, wr, wc, fr, fq, lds, wid, lane); S.done(cur); }
#undef PG8_SA
#undef PG8_SB
#undef PG8_STAGE
#undef PG8_LDA
#undef PG8_LDB
#undef PG8_MMA
#undef PG8_WAIT_V
#undef PG8_WAIT_L
#undef PG8_BAR
#undef PG8_SCHED
}
}

#ifndef MK_N_LAUNCHES
#define MK_N_LAUNCHES 1
#endif
#define LAS __attribute__((address_space(3)))
typedef unsigned short bf16_t;
typedef short bf16x8 __attribute__((ext_vector_type(8)));
typedef short s16x4 __attribute__((ext_vector_type(4)));
typedef float f32x4 __attribute__((ext_vector_type(4)));
typedef float f32x2 __attribute__((ext_vector_type(2)));
typedef float f32x16 __attribute__((ext_vector_type(16)));
typedef unsigned u32x4 __attribute__((ext_vector_type(4)));
typedef unsigned u32x2 __attribute__((ext_vector_type(2)));
typedef __bf16 bf16x2_t __attribute__((ext_vector_type(2)));

constexpr int DM = 1024, SEQ = 8192, NMETA = 16, LP = SEQ + NMETA, NB = 2, DBATCH = 16, DSEQ = 16, PAST = 1024, NH = 8, DH = 64, WA = 512, WC = 512, NIN = 4104;
constexpr int NPROW = NB * LP;
constexpr int NSROW = DBATCH * DSEQ;
constexpr int NROW = NPROW + NSROW;
constexpr int MG = NB * SEQ;
constexpr int HROWS = MG + NSROW + NMETA;
constexpr int MOUT = MG + NSROW;
constexpr int LPP = 8320;
constexpr int SPP = 1088;
constexpr int SRC_BG = 2056, SRC_CG = 2568, SRC_HC = 3080, SRC_ZC = 3592, SRC_FL = 2048;
constexpr float LOG2E = 1.4426950408889634f, C2Q = 0.125f * 1.4426950408889634f, EPS = 1e-6f, NEGBIG = -1e30f;

constexpr size_t O_YP = 0, O_YS = 16777216, O_KP = 17039360, O_VP = 25444352, O_FP = 33849344, O_CP = 33980672, O_KS = 33982720, O_VS = 34113792, O_FS = 34244864, O_CS = 34246912;

constexpr size_t MiB = 1u << 20;
constexpr size_t WS_CTL = 0, WS_WIN = 1 * MiB, WS_WOUT = 9 * MiB, WS_H = 11 * MiB, WS_A2 = 44 * MiB, WS_Q = 77 * MiB, WS_K = 94 * MiB, WS_VT = 111 * MiB, WS_SZA = 128 * MiB,
                 WS_U = 145 * MiB, WS_G = 162 * MiB, WS_LOGF = 179 * MiB, WS_C2T = 180 * MiB, WS_C2S = 181 * MiB, WS_SSQ = 182 * MiB, WS_SSQS = 184 * MiB, WS_END = 185 * MiB;
constexpr int CTL_KMAX = 0, CW_BAR = 4096, CW_SEAM = 16384, CW_SEAM2 = 20480, CTL_ZERO_BYTES = 98304;

struct Params {
    const float *x_prompt, *x_sample, *cache_k, *cache_v, *cache_logf, *state_conv, *meta, *norm_g, *w_in, *b_f, *conv_w, *w_out, *final_g;
    float* out; unsigned char* ws; int ph_lo, ph_hi;
};

__device__ __forceinline__ unsigned cvtpk(float lo, float hi) { f32x2 v = {lo, hi}; bf16x2_t b = __builtin_convertvector(v, bf16x2_t); return __builtin_bit_cast(unsigned, b); }
__device__ __forceinline__ float bf2f(unsigned short x) { return __uint_as_float(((unsigned)x) << 16); }
template <int CTRL> __device__ __forceinline__ float dppf(float v) { return __uint_as_float((unsigned)__builtin_amdgcn_update_dpp(0, (int)__float_as_uint(v), CTRL, 0xF, 0xF, true)); }
__device__ __forceinline__ void swap16(float v, float& a, float& b) { const auto rr = __builtin_amdgcn_permlane16_swap(__float_as_uint(v), __float_as_uint(v), false, false); a = __uint_as_float(rr[0]); b = __uint_as_float(rr[1]); }
__device__ __forceinline__ void swap32(float v, float& a, float& b) { const auto rr = __builtin_amdgcn_permlane32_swap(__float_as_uint(v), __float_as_uint(v), false, false); a = __uint_as_float(rr[0]); b = __uint_as_float(rr[1]); }
__device__ __forceinline__ float sum_x16(float v) { float a, b; swap16(v, a, b); return a + b; }
__device__ __forceinline__ float sum_x32(float v) { float a, b; swap32(v, a, b); return a + b; }
__device__ __forceinline__ float max_x16(float v) { float a, b; swap16(v, a, b); return fmaxf(a, b); }
__device__ __forceinline__ float max_x32(float v) { float a, b; swap32(v, a, b); return fmaxf(a, b); }
template <int CTRL, int RMASK> __device__ __forceinline__ float dppz(float v) { return __uint_as_float((unsigned)__builtin_amdgcn_update_dpp(0, (int)__float_as_uint(v), CTRL, RMASK, 0xF, true)); }
__device__ __forceinline__ float wave_iscan(float v) { v += dppz<0x111, 0xF>(v); v += dppz<0x112, 0xF>(v); v += dppz<0x114, 0xF>(v); v += dppz<0x118, 0xF>(v); v += dppz<0x142, 0xA>(v); v += dppz<0x143, 0xC>(v); return v; }
__device__ __forceinline__ float wave_sum(float v) { v += dppf<0xB1>(v); v += dppf<0x4E>(v); v += dppf<0x141>(v); v += dppf<0x140>(v); v = sum_x16(v); return sum_x32(v); }
__device__ __forceinline__ float row16_max(float v) { v = fmaxf(v, dppf<0xB1>(v)); v = fmaxf(v, dppf<0x4E>(v)); v = fmaxf(v, dppf<0x141>(v)); return fmaxf(v, dppf<0x140>(v)); }
__device__ __forceinline__ float wave_max(float v) { v = row16_max(v); v = max_x16(v); return max_x32(v); }
__device__ __forceinline__ float wave_min(float v) { return -wave_max(-v); }
__device__ __forceinline__ float max3f(float a, float b, float c) { float r; asm("v_max3_f32 %0, %1, %2, %3" : "=v"(r) : "v"(a), "v"(b), "v"(c)); return r; }
__device__ __forceinline__ float silu_f(float v) { return v * __builtin_amdgcn_rcpf(1.0f + __builtin_amdgcn_exp2f(v * -1.4426950408889634f)); }
__device__ __forceinline__ int crow(int r, int hi) { return (r & 3) + 8 * (r >> 2) + 4 * hi; }
__device__ __forceinline__ bf16x8 pack8(float a, float b, float c, float d, float e, float f, float g, float h) {
    u32x4 p; p.x = cvtpk(a, b); p.y = cvtpk(c, d); p.z = cvtpk(e, f); p.w = cvtpk(g, h); return __builtin_bit_cast(bf16x8, p); }
#define MFMA32(a, b, c) __builtin_amdgcn_mfma_f32_32x32x16_bf16((a), (b), (c), 0, 0, 0)
#define MFMA16(a, b, c) __builtin_amdgcn_mfma_f32_16x16x32_bf16((a), (b), (c), 0, 0, 0)

__device__ __forceinline__ float* kout_ptr(float* out, int prow) { return prow < NPROW ? out + O_KP + (size_t)prow * 512 : out + O_KS + (size_t)(prow - NPROW) * 512; }
__device__ __forceinline__ float* vout_ptr(float* out, int prow) { return prow < NPROW ? out + O_VP + (size_t)prow * 512 : out + O_VS + (size_t)(prow - NPROW) * 512; }

#define XB_TMO      128
#define XB_XCNT(j)  (256  + 64 * (j))
#define XB_XSUB(j)  (1280 + 64 * (j))
#define XB_XGEN(j)  (2304 + 64 * (j))
#define XB_TOP      3328
#define XB_TOPGEN   3392
#define XCD_BAR_WORDS 3456
#define XB_SPIN_CAP (1u << 18)

__device__ __forceinline__ unsigned xb_ld(unsigned* p)              { return __hip_atomic_load(p, __ATOMIC_RELAXED, __HIP_MEMORY_SCOPE_AGENT); }
__device__ __forceinline__ unsigned xb_add(unsigned* p, unsigned v) { return __hip_atomic_fetch_add(p, v, __ATOMIC_RELAXED, __HIP_MEMORY_SCOPE_AGENT); }
__device__ __forceinline__ unsigned xb_xcc_id() { return (unsigned)__builtin_amdgcn_s_getreg((3 << 11) | 20) & 0xFu; }
#define XB_SPIN(cond, bar) do { unsigned _sp = 0; while (cond) { __builtin_amdgcn_s_sleep(1); \
    if ((++_sp & 255u) == 0u) { if (xb_ld(&(bar)[XB_TMO])) break; if (_sp > XB_SPIN_CAP) { atomicAdd(&(bar)[XB_TMO], 1u); break; } } } } while (0)

struct XcdBarrier {
    unsigned* bar; unsigned x;
    volatile LAS unsigned* st;
};

__device__ __forceinline__ XcdBarrier xcd_barrier_post(unsigned* bar, volatile LAS unsigned* st) {
    XcdBarrier b; b.bar = bar; b.x = xb_xcc_id(); b.st = st;
    if (threadIdx.x == 0) (void)xb_add(&bar[XB_XCNT(b.x)], 1u);
    return b;
}
__device__ __forceinline__ void xcd_barrier_complete(unsigned* bar, unsigned x, unsigned& nloc, unsigned& nx) {
    const unsigned G = gridDim.x * gridDim.y * gridDim.z;
    unsigned sum, cnt, mine, sp = 0u;
    for (;;) {
        sum = 0u; cnt = 0u; mine = 0u;
#pragma unroll
        for (unsigned j = 0; j < 16; ++j) { const unsigned c = xb_ld(&bar[XB_XCNT(j)]); sum += c; cnt += (c > 0u) ? 1u : 0u; mine = (j == x) ? c : mine; }
        if (sum == G) break;
        __builtin_amdgcn_s_sleep(1);
        if ((++sp & 255u) == 0u) { if (xb_ld(&bar[XB_TMO])) break; if (sp > XB_SPIN_CAP) { atomicAdd(&bar[XB_TMO], 1u); break; } }
    }
    nloc = mine > 0u ? mine : 1u; nx = cnt > 0u ? cnt : 1u;
}

__device__ __forceinline__ void xcd_barrier(const XcdBarrier& b) {
    asm volatile("s_waitcnt vmcnt(0)" ::: "memory");
    __syncthreads();
    if (threadIdx.x == 0) {
        unsigned* bar = b.bar;
        __builtin_amdgcn_s_waitcnt(0);
        unsigned nloc = b.st[0], nx = b.st[1];
        if (nloc == 0u) { xcd_barrier_complete(bar, b.x, nloc, nx); b.st[0] = nloc; b.st[1] = nx; }
        const unsigned old = xb_add(&bar[XB_XSUB(b.x)], 1u);
        const unsigned gen = old / nloc;
        if (old + 1u == (gen + 1u) * nloc) {
            __builtin_amdgcn_fence(__ATOMIC_RELEASE, "agent");
            asm volatile("s_waitcnt vmcnt(0)" ::: "memory");
            const unsigned og = xb_add(&bar[XB_TOP], 1u);
            const unsigned tg = og / nx;
            if (og + 1u == (tg + 1u) * nx) xb_add(&bar[XB_TOPGEN], 1u);
            else XB_SPIN(xb_ld(&bar[XB_TOPGEN]) == tg, bar);
            __builtin_amdgcn_fence(__ATOMIC_ACQUIRE, "agent");
            xb_add(&bar[XB_XGEN(b.x)], 1u);
            asm volatile("s_waitcnt vmcnt(0)" ::: "memory");
        } else {
            XB_SPIN(xb_ld(&bar[XB_XGEN(b.x)]) == gen, bar);
            __builtin_amdgcn_fence(__ATOMIC_ACQUIRE, "agent");
            asm volatile("s_waitcnt vmcnt(0)" ::: "memory");
        }
    }
    __syncthreads();
}

struct Sink {
    float* out; bf16_t *Qb, *Kb, *Vt, *SZA, *U, *Gg;
    template <int cls> __device__ __forceinline__ void put(int prow, int c, f32x4 v, f32x4 w) const {
        if constexpr (cls == 0) { u32x2 o; o.x = cvtpk(v[0] * C2Q, v[1] * C2Q); o.y = cvtpk(v[2] * C2Q, v[3] * C2Q); *(u32x2*)(Qb + (size_t)prow * 512 + c) = o; }
        else if constexpr (cls == 1) { u32x2 o; o.x = cvtpk(v[0], v[1]); o.y = cvtpk(v[2], v[3]); *(u32x2*)(Kb + (size_t)prow * 512 + c) = o; *(f32x4*)(kout_ptr(out, prow) + c) = v; }
        else if constexpr (cls == 2) {
            *(f32x4*)(vout_ptr(out, prow) + c) = v;
            if (prow < NPROW) { const int b = prow >= LP ? 1 : 0, pos = prow - b * LP; bf16_t* p = Vt + (size_t)(b * 512 + c) * LPP + pos;
                const unsigned a = cvtpk(v[0], v[1]), d = cvtpk(v[2], v[3]);
                p[0] = (bf16_t)(a & 0xffffu); p[LPP] = (bf16_t)(a >> 16); p[2 * LPP] = (bf16_t)(d & 0xffffu); p[3 * LPP] = (bf16_t)(d >> 16); }
        }
        else if constexpr (cls == 3) { u32x2 o; o.x = cvtpk(silu_f(v[0]), silu_f(v[1])); o.y = cvtpk(silu_f(v[2]), silu_f(v[3])); *(u32x2*)(SZA + (size_t)prow * 512 + c) = o; }
        else if constexpr (cls == 4) { const f32x4 uu = v * w; u32x2 o; o.x = cvtpk(uu[0], uu[1]); o.y = cvtpk(uu[2], uu[3]); *(u32x2*)(U + (size_t)prow * 512 + c) = o;
            if (prow < NPROW) { const int b = prow >= LP ? 1 : 0, pos = prow - b * LP; if (pos >= LP - 2) *(f32x4*)(out + O_CP + (size_t)(b * 2 + (pos - (LP - 2))) * 512 + c) = uu; }
            else { const int sr = prow - NPROW, s = sr & 15; if (s >= 14) *(f32x4*)(out + O_CS + (size_t)((sr >> 4) * 2 + (s - 14)) * 512 + c) = uu; } }
        else { u32x2 o; o.x = cvtpk(v[0] * silu_f(w[0]), v[1] * silu_f(w[1])); o.y = cvtpk(v[2] * silu_f(w[2]), v[3] * silu_f(w[3])); *(u32x2*)(Gg + (size_t)prow * 512 + c) = o; }
    }
    template <int cls> __device__ __forceinline__ void put8(int prow, int c, f32x4 v0, f32x4 v1, f32x4 w0, f32x4 w1) const {
        if constexpr (cls == 0) { u32x4 o; o.x = cvtpk(v0[0] * C2Q, v0[1] * C2Q); o.y = cvtpk(v0[2] * C2Q, v0[3] * C2Q); o.z = cvtpk(v1[0] * C2Q, v1[1] * C2Q); o.w = cvtpk(v1[2] * C2Q, v1[3] * C2Q); *(u32x4*)(Qb + (size_t)prow * 512 + c) = o; }
        else if constexpr (cls == 1) { u32x4 o; o.x = cvtpk(v0[0], v0[1]); o.y = cvtpk(v0[2], v0[3]); o.z = cvtpk(v1[0], v1[1]); o.w = cvtpk(v1[2], v1[3]); *(u32x4*)(Kb + (size_t)prow * 512 + c) = o;
            float* kp = kout_ptr(out, prow) + c; *(f32x4*)kp = v0; *(f32x4*)(kp + 4) = v1; }
        else if constexpr (cls == 2) { float* vp = vout_ptr(out, prow) + c; *(f32x4*)vp = v0; *(f32x4*)(vp + 4) = v1;
            { const int b = prow >= LP ? 1 : 0, pos = prow - b * LP, odd = pos & 1; unsigned* p = (unsigned*)(Vt + (size_t)(b * 512 + c + odd) * LPP + (pos & ~1));
                const unsigned pk[4] = {cvtpk(v0[0], v0[1]), cvtpk(v0[2], v0[3]), cvtpk(v1[0], v1[1]), cvtpk(v1[2], v1[3])};
#pragma unroll
                for (int i = 0; i < 4; ++i) { const unsigned y = (unsigned)__builtin_amdgcn_update_dpp(0, (int)pk[i], 0xB1, 0xF, 0xF, true);
                    const unsigned o = odd ? ((y >> 16) | (pk[i] & 0xffff0000u)) : ((pk[i] & 0xffffu) | (y << 16));
                    p[(size_t)i * LPP] = o; } } }
        else if constexpr (cls == 3) { u32x4 o; o.x = cvtpk(silu_f(v0[0]), silu_f(v0[1])); o.y = cvtpk(silu_f(v0[2]), silu_f(v0[3])); o.z = cvtpk(silu_f(v1[0]), silu_f(v1[1])); o.w = cvtpk(silu_f(v1[2]), silu_f(v1[3])); *(u32x4*)(SZA + (size_t)prow * 512 + c) = o; }
        else if constexpr (cls == 4) { const f32x4 u0 = v0 * w0, u1 = v1 * w1; u32x4 o; o.x = cvtpk(u0[0], u0[1]); o.y = cvtpk(u0[2], u0[3]); o.z = cvtpk(u1[0], u1[1]); o.w = cvtpk(u1[2], u1[3]); *(u32x4*)(U + (size_t)prow * 512 + c) = o;
            if (prow < NPROW) { const int b = prow >= LP ? 1 : 0, pos = prow - b * LP; if (pos >= LP - 2) { float* cp = out + O_CP + (size_t)(b * 2 + (pos - (LP - 2))) * 512 + c; *(f32x4*)cp = u0; *(f32x4*)(cp + 4) = u1; } } }
        else { u32x4 o; o.x = cvtpk(v0[0] * silu_f(w0[0]), v0[1] * silu_f(w0[1])); o.y = cvtpk(v0[2] * silu_f(w0[2]), v0[3] * silu_f(w0[3])); o.z = cvtpk(v1[0] * silu_f(w1[0]), v1[1] * silu_f(w1[1])); o.w = cvtpk(v1[2] * silu_f(w1[2]), v1[3] * silu_f(w1[3])); *(u32x4*)(Gg + (size_t)prow * 512 + c) = o; }
    }
};

__device__ __forceinline__ void mini_out_begin(const Params& P, LAS unsigned char* lds);
namespace pg8 {
struct EpiIn {
    static constexpr bool PERM = true, AFTER_DRAIN = false, INIT_ACC = false;
    Sink S; unsigned* kmax;
    template <int CLS> __device__ __forceinline__ void single(const f32x4 (&acc)[2][2][4][2], const Unit& u, int wr, int wc, int fr, int fq) const {
        const int pn = u.pn, b = u.pm >> 5, rbase = u.pm * BM + wr * 64 + fr, cb = (pn & 1) * 256 + wc * 32 + 8 * fq;
        float kq[2] = {0.f, 0.f};
#pragma unroll
        for (int ai = 0; ai < 2; ++ai)
#pragma unroll
            for (int m = 0; m < 4; ++m) { const int R = rbase + ai * HALF + m * 16; const int prow = b * LP + NMETA + (R & (SEQ - 1));
#pragma unroll
                for (int bj = 0; bj < 2; ++bj) { const f32x4 v0 = acc[ai][bj][m][0], v1 = acc[ai][bj][m][1]; S.template put8<CLS>(prow, cb + bj * HALF, v0, v1, v0, v1);
                    if constexpr (CLS == 1) { const float s = ((v0[0] * v0[0] + v0[1] * v0[1]) + (v0[2] * v0[2] + v0[3] * v0[3])) + ((v1[0] * v1[0] + v1[1] * v1[1]) + (v1[2] * v1[2] + v1[3] * v1[3])); kq[bj] = fmaxf(kq[bj], s); } } }
        if constexpr (CLS == 1) {
#pragma unroll
            for (int bj = 0; bj < 2; ++bj) { float s = sum_x16(kq[bj]); s = row16_max(s);
                const int head = (pn & 1) * 4 + 2 * bj + (wc >> 1), quarter = 2 * (wc & 1) + (fq >> 1);
                if (fr == 0 && (fq & 1) == 0) atomicMax(kmax + (b * 8 + head) * 4 + quarter, __float_as_uint(s)); }
        }
    }
    template <int CLS> __device__ __forceinline__ void paired(const f32x4 (&acc)[2][2][4][2], const Unit& u, int wr, int wc, int fr, int fq) const {
        const int pn = u.pn, b = u.pm >> 5, rbase = u.pm * BM + wr * 64 + fr, cb = ((pn - 8) & 3) * 128 + wc * 32 + 8 * fq;
#pragma unroll
        for (int ai = 0; ai < 2; ++ai)
#pragma unroll
            for (int m = 0; m < 4; ++m) { const int R = rbase + ai * HALF + m * 16; const int prow = b * LP + NMETA + (R & (SEQ - 1));
                S.template put8<CLS>(prow, cb, acc[ai][0][m][0], acc[ai][0][m][1], acc[ai][1][m][0], acc[ai][1][m][1]); }
    }
    __device__ __forceinline__ void operator()(const f32x4 (&acc)[2][2][4][2], const Unit& u, int wr, int wc, int fr, int fq) const {
        const int pn = u.pn;
        if (pn < 2) single<0>(acc, u, wr, wc, fr, fq); else if (pn < 4) single<1>(acc, u, wr, wc, fr, fq); else if (pn < 6) single<2>(acc, u, wr, wc, fr, fq); else if (pn < 8) single<3>(acc, u, wr, wc, fr, fq);
        else if (pn < 12) paired<4>(acc, u, wr, wc, fr, fq); else paired<5>(acc, u, wr, wc, fr, fq);
    }
};
struct EpiOut {
    static constexpr bool PERM = false, AFTER_DRAIN = false, INIT_ACC = false;
    const float* x; float* y; float* ssq;
    __device__ __forceinline__ void operator()(const f32x4 (&acc)[2][2][4][2], const Unit& u, int wr, int wc, int fr, int fq) const {
        const int col0 = u.pn * BM + wc * 32 + 4 * fq;
#pragma unroll
        for (int ai = 0; ai < 2; ++ai)
#pragma unroll
            for (int m = 0; m < 4; ++m) { const int R = u.pm * BM + ai * HALF + wr * 64 + m * 16 + fr; const size_t off = (size_t)R * DM + col0; float s = 0.f;
#pragma unroll
                for (int bj = 0; bj < 2; ++bj)
#pragma unroll
                    for (int n = 0; n < 2; ++n) { const f32x4 xv = *(const f32x4*)(x + off + bj * HALF + n * 16); const f32x4 o = xv + acc[ai][bj][m][n];
                        *(f32x4*)(y + off + bj * HALF + n * 16) = o; s += (o[0] * o[0] + o[1] * o[1]) + (o[2] * o[2] + o[3] * o[3]); }
                s = sum_x32(sum_x16(s));
                if (fq == 0) ssq[(size_t)R * 16 + u.pn * 4 + wc] = s; }
    }
};
struct EpiOutNorm {
    static constexpr bool PERM = false, AFTER_DRAIN = true, INIT_ACC = true;
    const float* x; float* y; const float* g; unsigned* xbuf; unsigned* cnt; const Params* prm;
    __device__ __forceinline__ void after_init(PG8_LAS unsigned char* lds) const { mini_out_begin(*prm, lds); __syncthreads(); }
    __device__ __forceinline__ void init_acc(f32x4 (&acc)[2][2][4][2], const Unit& u, int wr, int wc, int fr, int fq) const {
        const int col0 = u.pn * BM + wc * 32 + 4 * fq;
#pragma unroll
        for (int ai = 0; ai < 2; ++ai)
#pragma unroll
            for (int m = 0; m < 4; ++m) { const size_t off = (size_t)(u.pm * BM + ai * HALF + wr * 64 + m * 16 + fr) * DM + col0;
#pragma unroll
                for (int bj = 0; bj < 2; ++bj)
#pragma unroll
                    for (int n = 0; n < 2; ++n) acc[ai][bj][m][n] = *(const f32x4*)(x + off + bj * HALF + n * 16); }
    }
    __device__ __forceinline__ void fused(f32x4 (&acc)[2][2][4][2], const Unit& u, int wr, int wc, int fr, int fq, PG8_LAS unsigned char* lds, int wid, int lane) const {
        PG8_LAS float* Pp = (PG8_LAS float*)lds; PG8_LAS float* Sr = (PG8_LAS float*)(lds + 4096);
        const int col0 = u.pn * BM + wc * 32 + 4 * fq;
#pragma unroll
        for (int ai = 0; ai < 2; ++ai)
#pragma unroll
            for (int m = 0; m < 4; ++m) { const int rl = ai * HALF + wr * 64 + m * 16 + fr; float s = 0.f;
#pragma unroll
                for (int bj = 0; bj < 2; ++bj)
#pragma unroll
                    for (int n = 0; n < 2; ++n) { const f32x4 o = acc[ai][bj][m][n]; const f32x4 q = o * o; s += (q[0] + q[1]) + (q[2] + q[3]); }
                s = sum_x32(sum_x16(s));
                if (fq == 0) Pp[rl * 4 + wc] = s; }
        asm volatile("s_waitcnt lgkmcnt(0)" ::: "memory"); __builtin_amdgcn_s_barrier(); asm volatile("" ::: "memory");
        const int row = wid * 32 + (lane & 31);
        if (lane < 32) { const float tot = (Pp[row * 4] + Pp[row * 4 + 1]) + (Pp[row * 4 + 2] + Pp[row * 4 + 3]);
            __hip_atomic_store(xbuf + (size_t)(u.pm * BM + row) * 4 + u.pn, __float_as_uint(tot), __ATOMIC_RELAXED, __HIP_MEMORY_SCOPE_AGENT); }
        asm volatile("s_waitcnt vmcnt(0)" ::: "memory");
        if (lane == 0) __hip_atomic_fetch_add(cnt + 64 * u.pm, 1u, __ATOMIC_RELAXED, __HIP_MEMORY_SCOPE_AGENT);
        if (wid == 0) { unsigned sp = 0;
            while ((unsigned)__builtin_amdgcn_readfirstlane(__hip_atomic_load(cnt + 64 * u.pm, __ATOMIC_RELAXED, __HIP_MEMORY_SCOPE_AGENT)) < 32u) { __builtin_amdgcn_s_sleep(2); if (++sp > (1u << 22)) break; }
            __builtin_amdgcn_fence(__ATOMIC_ACQUIRE, "agent"); }
        asm volatile("s_waitcnt vmcnt(0) lgkmcnt(0)" ::: "memory"); __builtin_amdgcn_s_barrier(); asm volatile("" ::: "memory");
        if (lane < 32) { const unsigned* slot = xbuf + (size_t)(u.pm * BM + row) * 4; float t = 0.f;
#pragma unroll
            for (int k = 0; k < 4; ++k) t += __uint_as_float(__hip_atomic_load(slot + k, __ATOMIC_RELAXED, __HIP_MEMORY_SCOPE_AGENT));
            Sr[row] = 1.0f / sqrtf(t * (1.0f / DM) + EPS); }
        asm volatile("s_waitcnt lgkmcnt(0)" ::: "memory"); __builtin_amdgcn_s_barrier(); asm volatile("" ::: "memory");
        f32x4 gv[2][2];
#pragma unroll
        for (int bj = 0; bj < 2; ++bj)
#pragma unroll
            for (int n = 0; n < 2; ++n) gv[bj][n] = *(const f32x4*)(g + col0 + bj * HALF + n * 16);
#pragma unroll
        for (int ai = 0; ai < 2; ++ai)
#pragma unroll
            for (int m = 0; m < 4; ++m) { const int rl = ai * HALF + wr * 64 + m * 16 + fr; const size_t off = (size_t)(u.pm * BM + rl) * DM + col0; const float rs = Sr[rl];
#pragma unroll
                for (int bj = 0; bj < 2; ++bj)
#pragma unroll
                    for (int n = 0; n < 2; ++n) *(f32x4*)(y + off + bj * HALF + n * 16) = acc[ai][bj][m][n] * rs * gv[bj][n]; }
    }
};
}

__device__ __forceinline__ void mini_mma(const bf16_t* A0, const bf16_t* W0, const bf16_t* W1, int lane, f32x4& acc0, f32x4& acc1) {
    const int fr = lane & 15, fq = lane >> 4;
    const bf16_t* ap = A0 + (size_t)fr * DM + 8 * fq; const bf16_t* w0 = W0 + (size_t)fr * DM + 8 * fq; const bf16_t* w1 = W1 + (size_t)fr * DM + 8 * fq;
    acc0 = (f32x4){0.f, 0.f, 0.f, 0.f}; acc1 = acc0;
#pragma unroll 8
    for (int k = 0; k < DM; k += 32) {
        const bf16x8 a = *(const bf16x8*)(ap + k), b0 = *(const bf16x8*)(w0 + k), b1 = *(const bf16x8*)(w1 + k);
        acc0 = MFMA16(b0, a, acc0); acc1 = MFMA16(b1, a, acc1);
    }
}

constexpr int MW_STRIDE = 2064;
__device__ __forceinline__ void mini_stage_w(LAS unsigned char* lds, const bf16_t* WT, int c0, int c1) {
    const int tid = threadIdx.x;
    u32x4 v[8];
#pragma unroll
    for (int i = 0; i < 8; ++i) { const int id = tid + 512 * i, row = id >> 7, ch = id & 127; v[i] = *(const u32x4*)(WT + (size_t)(row < 16 ? c0 + row : c1 + row - 16) * DM + ch * 8); }
#pragma unroll
    for (int i = 0; i < 8; ++i) { const int id = tid + 512 * i, row = id >> 7, ch = id & 127; *(LAS u32x4*)(lds + row * MW_STRIDE + ch * 16) = v[i]; }
}
__device__ __forceinline__ void mini_load_a(const bf16_t* A0, int lane, int kh, bf16x8 (&a)[16]) {
    const bf16_t* ap = A0 + (size_t)(lane & 15) * DM + 8 * (lane >> 4) + 512 * kh;
#pragma unroll
    for (int k = 0; k < 16; ++k) a[k] = *(const bf16x8*)(ap + 32 * k);
}
__device__ __forceinline__ void mini_mma_lds(const LAS unsigned char* lds, const bf16x8 (&a)[16], int lane, int kh, f32x4& acc0, f32x4& acc1) {
    const LAS unsigned char* w0 = lds + (lane & 15) * MW_STRIDE + (lane >> 4) * 16 + 1024 * kh; const LAS unsigned char* w1 = w0 + 16 * MW_STRIDE;
#pragma unroll
    for (int k = 0; k < 16; ++k) { const bf16x8 b0 = *(const LAS bf16x8*)(w0 + 64 * k), b1 = *(const LAS bf16x8*)(w1 + 64 * k); acc0 = MFMA16(b0, a[k], acc0); acc1 = MFMA16(b1, a[k], acc1); }
}

__device__ __forceinline__ unsigned f2bf(float f) { unsigned u = __builtin_bit_cast(unsigned, f); return (u + 0x7fffu + ((u >> 16) & 1u)) >> 16; }
__device__ __forceinline__ unsigned pk2(float lo, float hi) { return f2bf(lo) | (f2bf(hi) << 16); }
__device__ __forceinline__ void transpose_item(const float* W, int ldw, int src0, bf16_t* WT, int dst0, int k0, LAS float* scr, int lane) {
    float tv[32];
#pragma unroll
    for (int i = 0; i < 32; ++i) { const int kk = 2 * i + (lane >> 5); tv[i] = W[(size_t)(k0 + kk) * ldw + src0 + (lane & 31)]; }
#pragma unroll
    for (int i = 0; i < 32; ++i) { const int kk = 2 * i + (lane >> 5); scr[kk * 33 + (lane & 31)] = tv[i]; }
    asm volatile("s_waitcnt lgkmcnt(0)" ::: "memory");
    const int c = lane & 7;
#pragma unroll
    for (int j = 0; j < 4; ++j) { const int n = (lane >> 3) + 8 * j; const LAS float* s = scr + (8 * c) * 33 + n;
        u32x4 o; o.x = cvtpk(s[0 * 33], s[1 * 33]); o.y = cvtpk(s[2 * 33], s[3 * 33]); o.z = cvtpk(s[4 * 33], s[5 * 33]); o.w = cvtpk(s[6 * 33], s[7 * 33]);
        *(u32x4*)(WT + (size_t)(dst0 + n) * DM + k0 + 8 * c) = o; }
    asm volatile("s_waitcnt lgkmcnt(0)" ::: "memory");
}
__device__ __forceinline__ int in_srccol(int n0) { const int tile = n0 >> 8, c = n0 & 255;
    if (tile < 8) return n0;
    if (tile < 12) { const int j = tile - 8; return c < 128 ? SRC_CG + 128 * j + c : SRC_HC + 128 * j + (c - 128); }
    const int j = tile - 12; return c < 128 ? SRC_BG + 128 * j + c : SRC_ZC + 128 * j + (c - 128); }

__device__ __forceinline__ void phase0(const Params& P, LAS unsigned char* lds) {
    const int tid = threadIdx.x, lane = tid & 63, wave = __builtin_amdgcn_readfirstlane(tid >> 6), G = gridDim.x, blk = blockIdx.x;
    unsigned char* ws = P.ws;
    bf16_t* WinT = (bf16_t*)(ws + WS_WIN); bf16_t* WoutT = (bf16_t*)(ws + WS_WOUT); bf16_t* H = (bf16_t*)(ws + WS_H); bf16_t* Vt = (bf16_t*)(ws + WS_VT);
    float* LOGF = (float*)(ws + WS_LOGF);
    for (int i = blk * 512 + tid; i < 1024 * 14; i += G * 512) { const int row = i / 14, ch = i % 14; *(u32x4*)(Vt + (size_t)row * LPP + LP + ch * 8) = (u32x4){0u, 0u, 0u, 0u}; }
    LAS float* wft = (LAS float*)(lds + 81920);
    for (int i = tid; i < 8192; i += 512) { const int k = i >> 3, e = i & 7; wft[e * 1024 + k] = P.w_in[(size_t)k * NIN + SRC_FL + e]; }
    LAS float* scr = (LAS float*)(lds + wave * 8448);
    const int gw = blk * 8 + wave, NGW = G * 8;
    for (int it = gw; it < 2048; it += NGW) { const int kb = it >> 7, nb = it & 127; transpose_item(P.w_in, NIN, in_srccol(nb * 32), WinT, nb * 32, kb * 64, scr, lane); }
    (void)WoutT;
    __syncthreads();
    f32x4 gv[4];
#pragma unroll
    for (int j = 0; j < 4; ++j) gv[j] = ((const f32x4*)P.norm_g)[lane + 64 * j];
    for (int Ra = gw; Ra < HROWS; Ra += 2 * NGW) {
        const int Rb = Ra + NGW; const bool hasb = Rb < HROWS; const int Rbb = hasb ? Rb : Ra;
        auto xrow = [&](int R) { return R < MG ? P.x_prompt + (size_t)R * DM : (R < MOUT ? P.x_sample + (size_t)(R - MG) * DM : P.meta + (size_t)(R - MOUT) * DM); };
        const float* xa = xrow(Ra); const float* xb = xrow(Rbb);
        f32x4 va[4], vb[4]; float sa = 0.f, sb = 0.f;
#pragma unroll
        for (int j = 0; j < 4; ++j) { va[j] = ((const f32x4*)xa)[lane + 64 * j]; vb[j] = ((const f32x4*)xb)[lane + 64 * j]; }
#pragma unroll
        for (int j = 0; j < 4; ++j) { const f32x4 qa = va[j] * va[j], qb = vb[j] * vb[j]; sa += (qa[0] + qa[1]) + (qa[2] + qa[3]); sb += (qb[0] + qb[1]) + (qb[2] + qb[3]); }
        sa = wave_sum(sa); sb = wave_sum(sb);
        const float ra = __builtin_amdgcn_rsqf(sa * (1.0f / DM) + EPS), rb = __builtin_amdgcn_rsqf(sb * (1.0f / DM) + EPS);
#pragma unroll
        for (int j = 0; j < 4; ++j) { va[j] = va[j] * ra * gv[j]; vb[j] = vb[j] * rb * gv[j];
            u32x2 o; o.x = cvtpk(va[j][0], va[j][1]); o.y = cvtpk(va[j][2], va[j][3]); *(u32x2*)(H + (size_t)Ra * DM + 4 * lane + 256 * j) = o;
            if (hasb) { u32x2 q; q.x = cvtpk(vb[j][0], vb[j][1]); q.y = cvtpk(vb[j][2], vb[j][3]); *(u32x2*)(H + (size_t)Rb * DM + 4 * lane + 256 * j) = q; } }
        float r1[8];
#pragma unroll
        for (int e = 0; e < 8; ++e) { f32x2 a2 = {0.f, 0.f}, c2 = {0.f, 0.f};
#pragma unroll
            for (int j = 0; j < 4; ++j) { const f32x4 wv = *(const LAS f32x4*)(wft + e * 1024 + 256 * j + 4 * lane);
                const f32x2 w01 = {wv[0], wv[1]}, w23 = {wv[2], wv[3]};
                a2 = (f32x2){va[j][0], va[j][1]} * w01 + a2; a2 = (f32x2){va[j][2], va[j][3]} * w23 + a2;
                c2 = (f32x2){vb[j][0], vb[j][1]} * w01 + c2; c2 = (f32x2){vb[j][2], vb[j][3]} * w23 + c2; }
            const auto rr = __builtin_amdgcn_permlane32_swap(__float_as_uint(a2[0] + a2[1]), __float_as_uint(c2[0] + c2[1]), false, false);
            r1[e] = __uint_as_float(rr[0]) + __uint_as_float(rr[1]); }
        float r2[4];
#pragma unroll
        for (int i = 0; i < 4; ++i) { const auto rr = __builtin_amdgcn_permlane16_swap(__float_as_uint(r1[2 * i]), __float_as_uint(r1[2 * i + 1]), false, false);
            float v = __uint_as_float(rr[0]) + __uint_as_float(rr[1]);
            v += dppf<0xB1>(v); v += dppf<0x4E>(v); v += dppf<0x141>(v); v += dppf<0x140>(v); r2[i] = v; }
        { const int i4 = lane & 15, rho = lane >> 4;
          float val = r2[0]; val = i4 == 1 ? r2[1] : val; val = i4 == 2 ? r2[2] : val; val = i4 == 3 ? r2[3] : val;
          if (i4 < 4) {
            const int e = 2 * i4 + (rho & 1); const bool isb = rho >= 2; const int R = isb ? Rb : Ra;
            if (!isb || hasb) {
                const float yv = val + P.b_f[e];
                const float lf = fminf(yv, 0.f) - __logf(1.0f + __expf(-fabsf(yv)));
                if (R < MG) { const int b = R >> 13, prow = b * LP + NMETA + (R & (SEQ - 1)); LOGF[(size_t)prow * 8 + e] = lf; P.out[O_FP + (size_t)prow * 8 + e] = lf; }
                else if (R < MOUT) { const int sr = R - MG; LOGF[(size_t)(NPROW + sr) * 8 + e] = lf; P.out[O_FS + (size_t)sr * 8 + e] = lf; }
                else { const int j = R - MOUT;
#pragma unroll
                    for (int b = 0; b < 2; ++b) { const int prow = b * LP + j; LOGF[(size_t)prow * 8 + e] = lf; P.out[O_FP + (size_t)prow * 8 + e] = lf; } }
            } } }
    }
}

__device__ __forceinline__ void mini_inproj(const Params& P, const Sink& S, unsigned* kmax, LAS unsigned char* lds) {
    const int tid = threadIdx.x, lane = tid & 63, wave = __builtin_amdgcn_readfirstlane(tid >> 6), G = gridDim.x, fr = lane & 15, fq = lane >> 4;
    const bf16_t* WinT = (const bf16_t*)(P.ws + WS_WIN); const bf16_t* H = (const bf16_t*)(P.ws + WS_H);
    for (int it = blockIdx.x; it < 256; it += G) {
        const int p = it >> 1, half = it & 1;
        int c0, c1, cls, cc;
        if (p < 64) { c0 = 32 * p; c1 = c0 + 16; cls = c0 >> 9; cc = c0 & 511; }
        else { const int pp = p - 64, tile = 8 + (pp >> 3), sub = pp & 7; c0 = tile * 256 + 16 * sub; c1 = c0 + 128; cls = tile < 12 ? 4 : 5; cc = ((tile - 8) & 3) * 128 + 16 * sub; }
        const int nq = (half == 0) ? 2 : 1;
        __syncthreads();
        mini_stage_w(lds, WinT, c0, c1);
        __syncthreads();
#pragma unroll 1
        for (int q = 0; q < nq; ++q) {
            asm volatile("" ::: "memory");
            const int rf = half == 0 ? (q == 0 ? wave : 8) : 9 + wave;
            const bf16_t* Ar = H + (size_t)(MG + 16 * rf) * DM;
            f32x4 a0 = (f32x4){0.f, 0.f, 0.f, 0.f}, a1 = a0;
            if (q == 0) {
                bf16x8 af[16], ag[16];
                mini_load_a(Ar, lane, 0, af);
                mini_load_a(Ar, lane, 1, ag);
                mini_mma_lds(lds, af, lane, 0, a0, a1);
                mini_mma_lds(lds, ag, lane, 1, a0, a1);
            } else {
                const bf16_t* ap = Ar + (size_t)fr * DM + 8 * fq;
                const LAS unsigned char* w0 = lds + fr * MW_STRIDE + fq * 16; const LAS unsigned char* w1 = w0 + 16 * MW_STRIDE;
                bf16x8 ak[4];
#pragma unroll
                for (int k = 0; k < 4; ++k) ak[k] = *(const bf16x8*)(ap + 32 * (4 * wave + k));
#pragma unroll
                for (int k = 0; k < 4; ++k) { const int kk = 4 * wave + k; const bf16x8 b0 = *(const LAS bf16x8*)(w0 + 64 * kk), b1 = *(const LAS bf16x8*)(w1 + 64 * kk); a0 = MFMA16(b0, ak[k], a0); a1 = MFMA16(b1, ak[k], a1); }
                LAS f32x4* part = (LAS f32x4*)(lds + 67584 + wave * 2048 + lane * 32);
                part[0] = a0; part[1] = a1;
                __syncthreads();
                if (wave != 0) break;
                a0 = (f32x4){0.f, 0.f, 0.f, 0.f}; a1 = a0;
#pragma unroll
                for (int wv = 0; wv < 8; ++wv) { const LAS f32x4* p = (const LAS f32x4*)(lds + 67584 + wv * 2048 + lane * 32); a0 += p[0]; a1 += p[1]; }
            }
            const int R = MG + 16 * rf + fr;
            const bool meta = R >= MOUT;
            const int prow = meta ? (R - MOUT) : NPROW + (R - MG);
#define MINI_PUT1(C) do { S.put<C>(prow, cc + 4 * fq, a0, a0); S.put<C>(prow, cc + 16 + 4 * fq, a1, a1); if (meta) { S.put<C>(prow + LP, cc + 4 * fq, a0, a0); S.put<C>(prow + LP, cc + 16 + 4 * fq, a1, a1); } } while (0)
#define MINI_PUT2(C) do { S.put<C>(prow, cc + 4 * fq, a0, a1); if (meta) S.put<C>(prow + LP, cc + 4 * fq, a0, a1); } while (0)
            switch (cls) { case 0: MINI_PUT1(0); break; case 1: MINI_PUT1(1); break; case 2: MINI_PUT1(2); break; case 3: MINI_PUT1(3); break; case 4: MINI_PUT2(4); break; default: MINI_PUT2(5); break; }
#undef MINI_PUT1
#undef MINI_PUT2
            if (cls == 1 && rf == 16) {
                float s0 = (a0[0] * a0[0] + a0[1] * a0[1]) + (a0[2] * a0[2] + a0[3] * a0[3]), s1 = (a1[0] * a1[0] + a1[1] * a1[1]) + (a1[2] * a1[2] + a1[3] * a1[3]);
                s0 = sum_x32(sum_x16(s0)); s1 = sum_x32(sum_x16(s1));
                s0 = row16_max(s0); s1 = row16_max(s1);
                if (lane == 0) { const int head = cc >> 6, qr = (cc >> 4) & 3;
                    atomicMax(kmax + (0 * 8 + head) * 4 + qr, __float_as_uint(s0)); atomicMax(kmax + (1 * 8 + head) * 4 + qr, __float_as_uint(s0));
                    atomicMax(kmax + (0 * 8 + head) * 4 + qr + 1, __float_as_uint(s1)); atomicMax(kmax + (1 * 8 + head) * 4 + qr + 1, __float_as_uint(s1)); }
            }
        }
    }
}

template <int NR, class GET> __device__ __forceinline__ float scan_load(float (&x)[NR], int row0, GET get, int lane) {
    float t = 0.f;
#pragma unroll
    for (int k = 0; k < NR; ++k) { x[k] = get(64 * (row0 + k) + lane); t += x[k]; }
    return t;
}
template <int NR> __device__ __forceinline__ void scan_store(const float (&x)[NR], int row0, int nrows, float carry, float* out, int lane) {
#pragma unroll
    for (int k = 0; k < NR; ++k) { if (row0 + k < nrows) { float inc = x[k];
            inc = wave_iscan(inc);
            out[64 * (row0 + k) + lane] = (carry + inc) * LOG2E; carry += __uint_as_float((unsigned)__builtin_amdgcn_readlane((int)__float_as_uint(inc), 63)); } }
}
__device__ __forceinline__ void scans(const Params& P, LAS unsigned char* lds) {
    const float* LOGF = (const float*)(P.ws + WS_LOGF); float* C2T = (float*)(P.ws + WS_C2T); float* C2S = (float*)(P.ws + WS_C2S);
    LAS float* sm = (LAS float*)lds;
    const int tid = threadIdx.x, lane = tid & 63, wave = __builtin_amdgcn_readfirstlane(tid >> 6);
    for (int job = blockIdx.x; job < 32; job += gridDim.x) {
        if (job < 16) {
            const int b = job >> 3, h = job & 7; const float* src = LOGF + (size_t)b * LP * 8 + h;
            float x[17];
            const float t = scan_load<17>(x, 17 * wave, [&](int pos) { return pos < LP ? src[(size_t)pos * 8] : 0.f; }, lane);
            const float tot = wave_sum(t);
            __syncthreads();
            if (lane == 0) sm[wave] = tot;
            __syncthreads();
            float carry = 0.f; for (int w = 0; w < wave; ++w) carry += sm[w];
            scan_store<17>(x, 17 * wave, LPP / 64, carry, C2T + (size_t)(b * 8 + h) * LPP, lane);
        } else {
            const int sb = job - 16, h = wave; const float* s0 = P.cache_logf + (size_t)sb * PAST * 8 + h; const float* s1 = LOGF + (size_t)(NPROW + sb * 16) * 8 + h;
            float x[17];
            (void)scan_load<17>(x, 0, [&](int pos) { return pos < PAST ? s0[(size_t)pos * 8] : (pos < PAST + DSEQ ? s1[(size_t)(pos - PAST) * 8] : 0.f); }, lane);
            scan_store<17>(x, 0, SPP / 64, 0.f, C2S + (size_t)(sb * 8 + h) * SPP, lane);
        }
    }
}

constexpr int KS_STRIDE = 144, VS_STRIDE = 272;
constexpr int B_KS = 0, B_VS = 128 * KS_STRIDE, B_CK = B_VS + 64 * VS_STRIDE, B_SIZE = B_CK + 576, L_FLAG = 2 * B_SIZE;

__device__ __forceinline__ void attn_prompt_unit(const Params& P, LAS unsigned char* lds, int b, int h, int jq) {
    const int tid = threadIdx.x, lane = tid & 63, w = __builtin_amdgcn_readfirstlane(tid >> 6), r32 = lane & 31, hi = lane >> 5;
    const bf16_t* Qb = (const bf16_t*)(P.ws + WS_Q); const bf16_t* Kb = (const bf16_t*)(P.ws + WS_K); const bf16_t* Vt = (const bf16_t*)(P.ws + WS_VT);
    const bf16_t* SZA = (const bf16_t*)(P.ws + WS_SZA); bf16_t* A2 = (bf16_t*)(P.ws + WS_A2);
    const float* c2t = (const float*)(P.ws + WS_C2T) + (size_t)(b * 8 + h) * LPP;
    const unsigned* kmaxp = (const unsigned*)(P.ws + WS_CTL) + CTL_KMAX + (b * 8 + h) * 4;
    const int q0 = NMETA + 256 * jq, qlo = q0 + 32 * w, qpos = qlo + r32;
    const size_t prow_q = (size_t)b * LP + qpos;
    const int T_hi = (q0 + 255) >> 7;
    const bf16_t* ksrc = Kb + ((size_t)b * LP + (tid >> 3)) * 512 + h * 64 + (tid & 7) * 8;
    const bf16_t* vsrc = Vt + (size_t)((b * 8 + h) * 64 + (tid >> 4)) * LPP + (tid & 15) * 8;
    const int kdst = B_KS + (tid >> 3) * KS_STRIDE + (tid & 7) * 16, vdst = B_VS + (tid >> 4) * VS_STRIDE + ((tid & 15) >> 1) * 32 + ((tid & 1) ? 8 : 0);
    LAS unsigned* flg = (LAS unsigned*)(lds + L_FLAG);
    u32x4 kA0, kA1, vA0, vA1, kB0, kB1, vB0, vB1; float cA = 0.f, cB = 0.f;
#define ATT_PREFETCH(T, k0, k1, v0, v1, cc) do { k0 = *(const u32x4*)(ksrc + (size_t)(T) * 128 * 512); k1 = *(const u32x4*)(ksrc + ((size_t)(T) * 128 + 64) * 512); \
        v0 = *(const u32x4*)(vsrc + (T) * 128); v1 = *(const u32x4*)(vsrc + (size_t)32 * LPP + (T) * 128); \
        if (tid < 129) { const int ci = 128 * (T) - 1 + tid; cc = c2t[ci < 0 ? 0 : ci]; } } while (0)
    __syncthreads();
    ATT_PREFETCH(T_hi, kA0, kA1, vA0, vA1, cA);
    if (T_hi >= 1) ATT_PREFETCH(T_hi - 1, kB0, kB1, vB0, vB1, cB);
    bf16x8 qf[4]; float qn2 = 0.f;
#pragma unroll
    for (int j = 0; j < 4; ++j) { qf[j] = *(const bf16x8*)(Qb + prow_q * 512 + h * 64 + 16 * j + 8 * hi);
#pragma unroll
        for (int e = 0; e < 8; ++e) { const float x = bf2f((unsigned short)qf[j][e]); qn2 += x * x; } }
    qn2 = sum_x32(qn2);
    const float qnmax = sqrtf(wave_max(qn2));
    const float c2q = c2t[qpos];
    const float c2qmax = wave_max(c2q);
    float k2 = 0.f;
#pragma unroll
    for (int i = 0; i < 4; ++i) k2 += __uint_as_float(__hip_atomic_load(kmaxp + i, __ATOMIC_RELAXED, __HIP_MEMORY_SCOPE_AGENT));
    const float qk_bound = qnmax * sqrtf(k2) * 1.03f + 1.0f;
    float mref = 0.f, l = 0.f; bool seen = false; f32x16 o0, o1, cq16;
#pragma unroll
    for (int r = 0; r < 16; ++r) { o0[r] = 0.f; o1[r] = 0.f; cq16[r] = c2q; }
    bool active = true;
    auto step = [&](int T, int par, u32x4& k0, u32x4& k1, u32x4& v0, u32x4& v1, float& cc) __attribute__((always_inline)) -> bool {
        LAS unsigned char* buf = lds + par * B_SIZE;
        *(LAS u32x4*)(buf + kdst) = k0; *(LAS u32x4*)(buf + kdst + 64 * KS_STRIDE) = k1;
        *(LAS u32x2*)(buf + vdst) = (u32x2){v0.x, v0.y}; *(LAS u32x2*)(buf + vdst + 16) = (u32x2){v0.z, v0.w};
        *(LAS u32x2*)(buf + vdst + 32 * VS_STRIDE) = (u32x2){v1.x, v1.y}; *(LAS u32x2*)(buf + vdst + 32 * VS_STRIDE + 16) = (u32x2){v1.z, v1.w};
        if (tid < 129) ((LAS float*)(buf + B_CK))[3 + tid] = cc;
        if (lane == 0) flg[par * 8 + w] = active ? 1u : 0u;
        if (T >= 2) ATT_PREFETCH(T - 2, k0, k1, v0, v1, cc);
        __syncthreads();
        unsigned any = 0u;
#pragma unroll
        for (int i = 0; i < 8; ++i) any |= flg[par * 8 + i];
        if (!any) return false;
        const LAS float* ckl = (const LAS float*)(buf + B_CK);
#pragma unroll
        for (int half = 1; half >= 0; --half) {
            const int t = 2 * T + half, kv0 = 64 * t;
            if (active && kv0 <= qlo + 31) {
                const LAS unsigned char* kb = buf + B_KS + half * 64 * KS_STRIDE; const LAS unsigned char* vb = buf + B_VS + half * 128; const LAS float* ck = ckl + half * 64 + 4;
                f32x16 p0, p1;
#pragma unroll
                for (int j = 0; j < 4; ++j) {
                    const bf16x8 a0 = *(const LAS bf16x8*)(kb + r32 * KS_STRIDE + (16 * j + 8 * hi) * 2);
                    const bf16x8 a1 = *(const LAS bf16x8*)(kb + (32 + r32) * KS_STRIDE + (16 * j + 8 * hi) * 2);
                    if (j == 0) { p0 = MFMA32(a0, qf[0], cq16); p1 = MFMA32(a1, qf[0], cq16); } else { p0 = MFMA32(a0, qf[j], p0); p1 = MFMA32(a1, qf[j], p1); }
                }
                const bool diag = (kv0 + 63 > qlo);
                float mx = NEGBIG;
#pragma unroll
                for (int g4 = 0; g4 < 4; ++g4) { const f32x4 c0v = *(const LAS f32x4*)(ck + 8 * g4 + 4 * hi), c1v = *(const LAS f32x4*)(ck + 32 + 8 * g4 + 4 * hi);
#pragma unroll
                    for (int i = 0; i < 4; ++i) { const int r = 4 * g4 + i; p0[r] -= c0v[i]; p1[r] -= c1v[i]; } }
                if (diag) {
                    asm volatile("" ::: "memory");
#pragma unroll
                    for (int r = 0; r < 16; ++r) { const int kr = crow(r, hi); if (kv0 + kr > qpos) p0[r] = NEGBIG; if (kv0 + 32 + kr > qpos) p1[r] = NEGBIG; }
                    asm volatile("" ::: "memory");
                }
#pragma unroll
                for (int r = 0; r < 16; ++r) mx = max3f(mx, p0[r], p1[r]);
                { const auto rr = __builtin_amdgcn_permlane32_swap(__float_as_uint(mx), __float_as_uint(mx), false, false); mx = fmaxf(__uint_as_float(rr[0]), __uint_as_float(rr[1])); }
                const bool real = mx > -1e29f;
                const float delta = seen ? fmaxf(mx, 0.f) : (real ? mx : 0.f);
                if (__builtin_amdgcn_ballot_w64(delta != 0.f) != 0ull) {
                    const float alpha = seen ? __builtin_amdgcn_exp2f(-delta) : 1.0f;
                    mref += delta; const float cq = c2q - mref; l *= alpha;
#pragma unroll
                    for (int r = 0; r < 16; ++r) { p0[r] -= delta; p1[r] -= delta; o0[r] *= alpha; o1[r] *= alpha; cq16[r] = cq; }
                }
                seen = seen || real;
#pragma unroll
                for (int r = 0; r < 16; ++r) { p0[r] = __builtin_amdgcn_exp2f(p0[r]); p1[r] = __builtin_amdgcn_exp2f(p1[r]); l += p0[r] + p1[r]; }
                bf16x8 pb[4];
                pb[0] = pack8(p0[0], p0[1], p0[2], p0[3], p0[4], p0[5], p0[6], p0[7]); pb[1] = pack8(p0[8], p0[9], p0[10], p0[11], p0[12], p0[13], p0[14], p0[15]);
                pb[2] = pack8(p1[0], p1[1], p1[2], p1[3], p1[4], p1[5], p1[6], p1[7]); pb[3] = pack8(p1[8], p1[9], p1[10], p1[11], p1[12], p1[13], p1[14], p1[15]);
#pragma unroll
                for (int j = 0; j < 4; ++j) {
                    const LAS unsigned char* x0 = vb + r32 * VS_STRIDE + j * 32 + hi * 16;
                    const bf16x8 A0 = *(const LAS bf16x8*)x0, A1 = *(const LAS bf16x8*)(x0 + 32 * VS_STRIDE);
                    o0 = MFMA32(A0, pb[j], o0); o1 = MFMA32(A1, pb[j], o1);
                }
            }
            if (active && t > 0) {
                const float bound = qk_bound + (c2qmax - ckl[3 + half * 64]);
                const bool need = !(bound < (seen ? mref : NEGBIG) - 150.0f);
                if (__builtin_amdgcn_ballot_w64(need) == 0ull) active = false;
            }
        }
        return true;
    };
    for (int T = T_hi; T >= 0; T -= 2) {
        if (!step(T, 0, kA0, kA1, vA0, vA1, cA)) break;
        if (T < 1) break;
        if (!step(T - 1, 1, kB0, kB1, vB0, vB1, cB)) break;
    }
#undef ATT_PREFETCH
    const float inv = 1.0f / sum_x32(l);
    const size_t R = (size_t)b * SEQ + (qpos - NMETA);
#pragma unroll
    for (int d0 = 0; d0 < 2; ++d0)
#pragma unroll
        for (int g = 0; g < 4; g += 2) {
            const f32x16& o = d0 == 0 ? o0 : o1;
            float lo[4], up[4];
#pragma unroll
            for (int i = 0; i < 4; ++i) { const auto rr = __builtin_amdgcn_permlane32_swap(__float_as_uint(o[4 * g + i] * inv), __float_as_uint(o[4 * (g + 1) + i] * inv), false, false);
                lo[i] = __uint_as_float(rr[0]); up[i] = __uint_as_float(rr[1]); }
            const int d = 32 * d0 + 8 * (g + hi);
            const u32x4 z = *(const u32x4*)(SZA + prow_q * 512 + h * 64 + d);
            u32x4 ov;
            ov.x = cvtpk(lo[0] * __uint_as_float(z.x << 16), lo[1] * __uint_as_float(z.x & 0xffff0000u)); ov.y = cvtpk(lo[2] * __uint_as_float(z.y << 16), lo[3] * __uint_as_float(z.y & 0xffff0000u));
            ov.z = cvtpk(up[0] * __uint_as_float(z.z << 16), up[1] * __uint_as_float(z.z & 0xffff0000u)); ov.w = cvtpk(up[2] * __uint_as_float(z.w << 16), up[3] * __uint_as_float(z.w & 0xffff0000u));
            *(u32x4*)(A2 + R * DM + h * 64 + d) = ov; }
}

__device__ __forceinline__ void attn_sample_item(const Params& P, LAS unsigned char* lds, int sb, int h) {
    const int tid = threadIdx.x, lane = tid & 63, w = __builtin_amdgcn_readfirstlane(tid >> 6), r32 = lane & 31, hi = lane >> 5;
    const bf16_t* Qb = (const bf16_t*)(P.ws + WS_Q); const bf16_t* SZA = (const bf16_t*)(P.ws + WS_SZA); bf16_t* A2 = (bf16_t*)(P.ws + WS_A2);
    const float* c2s = (const float*)(P.ws + WS_C2S) + (size_t)(sb * 8 + h) * SPP;
    const float* kc = P.cache_k + (size_t)sb * PAST * 512 + h * 64; const float* vc = P.cache_v + (size_t)sb * PAST * 512 + h * 64;
    const float* kn = P.out + O_KS + (size_t)sb * DSEQ * 512 + h * 64; const float* vn = P.out + O_VS + (size_t)sb * DSEQ * 512 + h * 64;
    const int qi = r32 < 15 ? r32 : 15, qpos = PAST + qi;
    const size_t prow_q = (size_t)NPROW + sb * 16 + qi;
    bf16x8 qf[4];
#pragma unroll
    for (int j = 0; j < 4; ++j) qf[j] = *(const bf16x8*)(Qb + prow_q * 512 + h * 64 + 16 * j + 8 * hi);
    const float c2q = c2s[qpos];
    float m = NEGBIG, l = 0.f; f32x16 o0, o1;
#pragma unroll
    for (int r = 0; r < 16; ++r) { o0[r] = 0.f; o1[r] = 0.f; }
    const int ntl = (w == 0) ? 3 : 2;
    for (int ti = 0; ti < ntl; ++ti) {
        const int t = (ntl == 3) ? (ti == 0 ? 16 : (ti == 1 ? 8 : 0)) : (ti == 0 ? w + 8 : w), kv0 = 64 * t;
        auto krow = [&](int kvp) -> const float* { const int p = kvp < PAST + DSEQ ? kvp : PAST + DSEQ - 1; return p < PAST ? kc + (size_t)p * 512 : kn + (size_t)(p - PAST) * 512; };
        auto vrow = [&](int kvp) -> const float* { const int p = kvp < PAST + DSEQ ? kvp : PAST + DSEQ - 1; return p < PAST ? vc + (size_t)p * 512 : vn + (size_t)(p - PAST) * 512; };
        f32x16 p0, p1;
#pragma unroll
        for (int r = 0; r < 16; ++r) { p0[r] = 0.f; p1[r] = 0.f; }
        const float* k0p = krow(kv0 + r32) + 8 * hi; const float* k1p = krow(kv0 + 32 + r32) + 8 * hi;
        f32x4 kx[4][4];
#pragma unroll
        for (int j = 0; j < 4; ++j) { kx[j][0] = *(const f32x4*)(k0p + 16 * j); kx[j][1] = *(const f32x4*)(k0p + 16 * j + 4); kx[j][2] = *(const f32x4*)(k1p + 16 * j); kx[j][3] = *(const f32x4*)(k1p + 16 * j + 4); }
        float vx[4][8], vy[4][8];
#define SMP_LOAD_V() do { _Pragma("unroll") for (int j = 0; j < 4; ++j) _Pragma("unroll") for (int e = 0; e < 8; ++e) { \
            const float* vr = vrow(kv0 + 16 * j + (e & 3) + 8 * (e >> 2) + 4 * hi); vx[j][e] = vr[r32]; vy[j][e] = vr[32 + r32]; } } while (0)
        if (ti == 0) SMP_LOAD_V();
#pragma unroll
        for (int j = 0; j < 4; ++j) {
            const bf16x8 a0 = pack8(kx[j][0][0], kx[j][0][1], kx[j][0][2], kx[j][0][3], kx[j][1][0], kx[j][1][1], kx[j][1][2], kx[j][1][3]), a1 = pack8(kx[j][2][0], kx[j][2][1], kx[j][2][2], kx[j][2][3], kx[j][3][0], kx[j][3][1], kx[j][3][2], kx[j][3][3]);
            p0 = MFMA32(a0, qf[j], p0); p1 = MFMA32(a1, qf[j], p1);
        }
        float mx = NEGBIG;
#pragma unroll
        for (int g4 = 0; g4 < 4; ++g4) { const f32x4 c0v = *(const f32x4*)(c2s + kv0 + 8 * g4 + 4 * hi), c1v = *(const f32x4*)(c2s + kv0 + 32 + 8 * g4 + 4 * hi);
#pragma unroll
            for (int i = 0; i < 4; ++i) { const int r = 4 * g4 + i, kr = 8 * g4 + 4 * hi + i;
                float s0 = p0[r] + (c2q - c0v[i]), s1 = p1[r] + (c2q - c1v[i]);
                if (kv0 + kr > qpos) s0 = NEGBIG; if (kv0 + 32 + kr > qpos) s1 = NEGBIG;
                p0[r] = s0; p1[r] = s1; mx = fmaxf(mx, fmaxf(s0, s1)); } }
        mx = max_x32(mx);
        if (ti > 0) {
            if (__builtin_amdgcn_ballot_w64(!(mx < m - 150.0f)) == 0ull) continue;
            SMP_LOAD_V();
        }
        const float mn = fmaxf(m, mx), alpha = __builtin_amdgcn_exp2f(m - mn);
        float rs = 0.f;
#pragma unroll
        for (int r = 0; r < 16; ++r) { p0[r] = __builtin_amdgcn_exp2f(p0[r] - mn); p1[r] = __builtin_amdgcn_exp2f(p1[r] - mn); rs += p0[r] + p1[r]; }
        l = l * alpha + rs; m = mn;
#pragma unroll
        for (int r = 0; r < 16; ++r) { o0[r] *= alpha; o1[r] *= alpha; }
        bf16x8 pb[4];
        pb[0] = pack8(p0[0], p0[1], p0[2], p0[3], p0[4], p0[5], p0[6], p0[7]); pb[1] = pack8(p0[8], p0[9], p0[10], p0[11], p0[12], p0[13], p0[14], p0[15]);
        pb[2] = pack8(p1[0], p1[1], p1[2], p1[3], p1[4], p1[5], p1[6], p1[7]); pb[3] = pack8(p1[8], p1[9], p1[10], p1[11], p1[12], p1[13], p1[14], p1[15]);
#pragma unroll
        for (int j = 0; j < 4; ++j) {
            const bf16x8 A0 = pack8(vx[j][0], vx[j][1], vx[j][2], vx[j][3], vx[j][4], vx[j][5], vx[j][6], vx[j][7]), A1 = pack8(vy[j][0], vy[j][1], vy[j][2], vy[j][3], vy[j][4], vy[j][5], vy[j][6], vy[j][7]);
            o0 = MFMA32(A0, pb[j], o0); o1 = MFMA32(A1, pb[j], o1);
        }
    }
#undef SMP_LOAD_V
    LAS float* ow = (LAS float*)(lds + w * 8448); LAS float* mw = ow + 2048; LAS float* lw = mw + 32;
    const float lt = sum_x32(l);
#pragma unroll
    for (int r = 0; r < 16; ++r) { ow[crow(r, hi) * 32 + r32] = o0[r]; ow[(32 + crow(r, hi)) * 32 + r32] = o1[r]; }
    if (hi == 0) { mw[r32] = m; lw[r32] = lt; }
    __syncthreads();
    {
        const int q = tid & 15, dg = tid >> 4;
        float M = NEGBIG;
#pragma unroll
        for (int i = 0; i < 8; ++i) M = fmaxf(M, ((LAS float*)(lds + i * 8448))[2048 + q]);
        float den = 0.f, n0 = 0.f, n1 = 0.f;
#pragma unroll
        for (int i = 0; i < 8; ++i) { LAS float* oi = (LAS float*)(lds + i * 8448); const float f = __builtin_amdgcn_exp2f(oi[2048 + q] - M);
            den += f * oi[2080 + q]; n0 += f * oi[(2 * dg) * 32 + q]; n1 += f * oi[(2 * dg + 1) * 32 + q]; }
        const size_t pr = (size_t)NPROW + sb * 16 + q;
        const unsigned z = *(const unsigned*)(SZA + pr * 512 + h * 64 + 2 * dg);
        const float inv = 1.0f / den;
        *(unsigned*)(A2 + (size_t)(MG + sb * 16 + q) * DM + h * 64 + 2 * dg) = cvtpk(n0 * inv * __uint_as_float(z << 16), n1 * inv * __uint_as_float(z & 0xffff0000u));
    }
    __syncthreads();
}

__device__ __forceinline__ void unpack8(const u32x4 a, float (&u)[8]) {
#pragma unroll
    for (int e = 0; e < 4; ++e) { u[2 * e] = __uint_as_float(a[e] << 16); u[2 * e + 1] = __uint_as_float(a[e] & 0xffff0000u); } }
__device__ __forceinline__ void conv_chunks(const Params& P, int gw, int ngw) {
    const int lane = threadIdx.x & 63, c = 8 * lane;
    const bf16_t* U = (const bf16_t*)(P.ws + WS_U); const bf16_t* Gg = (const bf16_t*)(P.ws + WS_G); bf16_t* A2 = (bf16_t*)(P.ws + WS_A2);
    float w0[8], w1[8], w2[8];
#pragma unroll
    for (int e = 0; e < 8; ++e) { w0[e] = P.conv_w[c + e]; w1[e] = P.conv_w[512 + c + e]; w2[e] = P.conv_w[1024 + c + e]; }
    for (int ch = gw; ch < MOUT / 16; ch += ngw) {
        const int R0 = 16 * ch; int prow0; float um2[8], um1[8];
        if (ch < MG / 16) { const int b = R0 >> 13; prow0 = b * LP + NMETA + (R0 & (SEQ - 1));
            unpack8(*(const u32x4*)(U + (size_t)(prow0 - 2) * 512 + c), um2); unpack8(*(const u32x4*)(U + (size_t)(prow0 - 1) * 512 + c), um1); }
        else { const int sb = ch - MG / 16; prow0 = NPROW + 16 * sb; const float* st = P.state_conv + (size_t)sb * 2 * 512 + c;
#pragma unroll
            for (int e = 0; e < 8; ++e) { um2[e] = st[e]; um1[e] = st[512 + e]; } }
        u32x4 uq[16], gq[16];
#pragma unroll
        for (int i = 0; i < 16; ++i) { uq[i] = *(const u32x4*)(U + (size_t)(prow0 + i) * 512 + c); gq[i] = *(const u32x4*)(Gg + (size_t)(prow0 + i) * 512 + c); }
#pragma unroll
        for (int i = 0; i < 16; ++i) { float u0[8], g0[8]; unpack8(uq[i], u0); unpack8(gq[i], g0);
            u32x4 o;
#pragma unroll
            for (int e = 0; e < 4; ++e) { const float y0 = w0[2 * e] * um2[2 * e] + w1[2 * e] * um1[2 * e] + w2[2 * e] * u0[2 * e], y1 = w0[2 * e + 1] * um2[2 * e + 1] + w1[2 * e + 1] * um1[2 * e + 1] + w2[2 * e + 1] * u0[2 * e + 1];
                o[e] = cvtpk(g0[2 * e] * y0, g0[2 * e + 1] * y1); }
            *(u32x4*)(A2 + (size_t)(R0 + i) * DM + 512 + c) = o;
#pragma unroll
            for (int e = 0; e < 8; ++e) { um2[e] = um1[e]; um1[e] = u0[e]; } }
    }
}

__device__ __forceinline__ void phase2_mem(const Params& P, LAS unsigned char* lds) {
    const int G = gridDim.x, blk = blockIdx.x, wave = __builtin_amdgcn_readfirstlane(threadIdx.x >> 6);
    const int ncb = G >= 2 ? G / 2 : 1;
    __syncthreads();
#pragma unroll 1
    for (int s = G - 1 - blk; s < 128; s += G) attn_sample_item(P, lds, s >> 3, s & 7);
    if (blk < ncb) {
        { LAS float* scr = (LAS float*)(lds + wave * 8448); bf16_t* WoutT = (bf16_t*)(P.ws + WS_WOUT); const int lane = threadIdx.x & 63;
          for (int r = blk * 8 + wave; r < 512; r += ncb * 8) { const int kb = r >> 5, nb = r & 31; transpose_item(P.w_out, DM, nb * 32, WoutT, nb * 32, kb * 64, scr, lane); } }
        conv_chunks(P, blk * 8 + wave, ncb * 8);
    }
    __syncthreads();
}
__device__ __forceinline__ void phase2(const Params& P, LAS unsigned char* lds, const XcdBarrier& bar) {
    const int G = gridDim.x, blk = blockIdx.x;
    const bool first = ((blk >> 3) & 1) != 0;
    if (first) phase2_mem(P, lds);
#pragma unroll 1
    for (int u = blk; u < 512; u += G) attn_prompt_unit(P, lds, (u >> 3) & 1, u & 7, u >> 4);
    if (!first) phase2_mem(P, lds);
    __syncthreads();
}

__device__ __forceinline__ void mini_outproj(const Params& P) {
    const int tid = threadIdx.x, lane = tid & 63, wave = __builtin_amdgcn_readfirstlane(tid >> 6), fr = lane & 15, fq = lane >> 4;
    const bf16_t* WoutT = (const bf16_t*)(P.ws + WS_WOUT); const bf16_t* A2 = (const bf16_t*)(P.ws + WS_A2); float* ssqs = (float*)(P.ws + WS_SSQS);
    for (int wi = blockIdx.x * 8 + wave; wi < 512; wi += gridDim.x * 8) {
        const int rf = wi & 15, p = wi >> 4, c0 = 32 * p;
        f32x4 a0, a1;
        mini_mma(A2 + (size_t)(MG + 16 * rf) * DM, WoutT + (size_t)c0 * DM, WoutT + (size_t)(c0 + 16) * DM, lane, a0, a1);
        const int rs = 16 * rf + fr; const size_t off = (size_t)rs * DM + c0 + 4 * fq;
        const f32x4 v0 = *(const f32x4*)(P.x_sample + off) + a0, v1 = *(const f32x4*)(P.x_sample + off + 16) + a1;
        *(f32x4*)(P.out + O_YS + off) = v0; *(f32x4*)(P.out + O_YS + off + 16) = v1;
        float s = (v0[0] * v0[0] + v0[1] * v0[1]) + (v0[2] * v0[2] + v0[3] * v0[3]) + (v1[0] * v1[0] + v1[1] * v1[1]) + (v1[2] * v1[2] + v1[3] * v1[3]);
        s = sum_x32(sum_x16(s));
        if (fq == 0) ssqs[rs * 32 + p] = s;
    }
}
constexpr int LDS_STASH = 131072;
__device__ __forceinline__ void mini_out_begin(const Params& P, LAS unsigned char* lds) {
    const int tid = threadIdx.x, lane = tid & 63, wave = __builtin_amdgcn_readfirstlane(tid >> 6), fr = lane & 15, fq = lane >> 4, blk = blockIdx.x;
    if (blk >= 64) return;
    const bf16_t* WoutT = (const bf16_t*)(P.ws + WS_WOUT); const bf16_t* A2 = (const bf16_t*)(P.ws + WS_A2);
    unsigned* xs = (unsigned*)(P.ws + WS_SSQS); unsigned* cnt = (unsigned*)(P.ws + WS_CTL) + CW_SEAM2;
    const int p = blk >> 1, rf = 8 * (blk & 1) + wave, c0 = 32 * p;
    const int rs = 16 * rf + fr; const size_t off = (size_t)rs * DM + c0 + 4 * fq;
    const f32x4 xs0 = *(const f32x4*)(P.x_sample + off), xs1 = *(const f32x4*)(P.x_sample + off + 16);
    bf16x8 af[16];
    mini_load_a(A2 + (size_t)(MG + 16 * rf) * DM, lane, 0, af);
    mini_stage_w(lds, WoutT, c0, c0 + 16);
    __syncthreads();
    f32x4 a0 = (f32x4){0.f, 0.f, 0.f, 0.f}, a1 = a0;
    mini_mma_lds(lds, af, lane, 0, a0, a1);
    asm volatile("" ::: "memory");
    mini_load_a(A2 + (size_t)(MG + 16 * rf) * DM, lane, 1, af);
    mini_mma_lds(lds, af, lane, 1, a0, a1);
    const f32x4 v0 = xs0 + a0, v1 = xs1 + a1;
    float s = (v0[0] * v0[0] + v0[1] * v0[1]) + (v0[2] * v0[2] + v0[3] * v0[3]) + (v1[0] * v1[0] + v1[1] * v1[1]) + (v1[2] * v1[2] + v1[3] * v1[3]);
    s = sum_x32(sum_x16(s));
    if (fq == 0) __hip_atomic_store(xs + (size_t)rs * 32 + p, __float_as_uint(s), __ATOMIC_RELAXED, __HIP_MEMORY_SCOPE_AGENT);
    asm volatile("s_waitcnt vmcnt(0)" ::: "memory");
    if (lane == 0) __hip_atomic_fetch_add(cnt + 64 * rf, 1u, __ATOMIC_RELAXED, __HIP_MEMORY_SCOPE_AGENT);
    LAS f32x4* st = (LAS f32x4*)(lds + LDS_STASH + wave * 2048 + lane * 32);
    st[0] = v0; st[1] = v1;
}
__device__ __forceinline__ void mini_out_finish(const Params& P, LAS unsigned char* lds) {
    const int tid = threadIdx.x, lane = tid & 63, wave = __builtin_amdgcn_readfirstlane(tid >> 6), fr = lane & 15, fq = lane >> 4, blk = blockIdx.x;
    if (blk >= 64) return;
    const unsigned* xs = (const unsigned*)(P.ws + WS_SSQS); unsigned* cnt = (unsigned*)(P.ws + WS_CTL) + CW_SEAM2;
    const int p = blk >> 1, rf = 8 * (blk & 1) + wave, c0 = 32 * p;
    const int rs = 16 * rf + fr; const size_t off = (size_t)rs * DM + c0 + 4 * fq;
    const f32x4 g0 = *(const f32x4*)(P.final_g + c0 + 4 * fq), g1 = *(const f32x4*)(P.final_g + c0 + 16 + 4 * fq);
    { unsigned sp = 0;
      while ((unsigned)__builtin_amdgcn_readfirstlane(__hip_atomic_load(cnt + 64 * rf, __ATOMIC_RELAXED, __HIP_MEMORY_SCOPE_AGENT)) < 32u) { __builtin_amdgcn_s_sleep(2); if (++sp > (1u << 22)) break; }
      __builtin_amdgcn_fence(__ATOMIC_ACQUIRE, "agent"); }
    float t = 0.f;
#pragma unroll
    for (int k = 0; k < 8; ++k) t += __uint_as_float(__hip_atomic_load(xs + (size_t)rs * 32 + 8 * fq + k, __ATOMIC_RELAXED, __HIP_MEMORY_SCOPE_AGENT));
    t = sum_x32(sum_x16(t));
    const float rstd = 1.0f / sqrtf(t * (1.0f / DM) + EPS);
    const LAS f32x4* st = (const LAS f32x4*)(lds + LDS_STASH + wave * 2048 + lane * 32);
    const f32x4 v0 = st[0], v1 = st[1];
    *(f32x4*)(P.out + O_YS + off) = v0 * rstd * g0; *(f32x4*)(P.out + O_YS + off + 16) = v1 * rstd * g1;
}
__device__ __forceinline__ void phase4(const Params& P) {
    const int tid = threadIdx.x, lane = tid & 63, wave = __builtin_amdgcn_readfirstlane(tid >> 6);
    const float* ssq = (const float*)(P.ws + WS_SSQ); const float* ssqs = (const float*)(P.ws + WS_SSQS);
    f32x4 gv[4];
#pragma unroll
    for (int j = 0; j < 4; ++j) gv[j] = ((const f32x4*)P.final_g)[lane + 64 * j];
    for (int R = blockIdx.x * 8 + wave; R < MOUT; R += gridDim.x * 8) {
        float* y; float part;
        if (R < MG) { y = P.out + O_YP + (size_t)R * DM; part = lane < 16 ? ssq[(size_t)R * 16 + lane] : 0.f; }
        else { y = P.out + O_YS + (size_t)(R - MG) * DM; part = lane < 32 ? ssqs[(R - MG) * 32 + lane] : 0.f; }
        const float ss = wave_sum(part);
        const float rstd = 1.0f / sqrtf(ss * (1.0f / DM) + EPS);
#pragma unroll
        for (int j = 0; j < 4; ++j) { f32x4 v = ((f32x4*)y)[lane + 64 * j]; v = v * rstd * gv[j]; ((f32x4*)y)[lane + 64 * j] = v; }
    }
}

constexpr int LDS_BYTES = 149504;
__global__ void __launch_bounds__(512, 2) hymba_fwd(Params P) {
    extern __shared__ __attribute__((aligned(16))) unsigned char lds_raw[];
    LAS unsigned char* lds = (LAS unsigned char*)lds_raw;
    cg::grid_group grid = cg::this_grid();
    const int lo = P.ph_lo, hi = P.ph_hi;
    if (lo < 0) grid.sync();
    volatile LAS unsigned* bst = (volatile LAS unsigned*)(lds + LDS_BYTES - 64);
    if (threadIdx.x < 2) bst[threadIdx.x] = 0u;
    __syncthreads();
    XcdBarrier bar; bar.bar = (unsigned*)(P.ws + WS_CTL) + CW_BAR; bar.x = 0; bar.st = bst;
    if (hi - lo > 1) bar = xcd_barrier_post((unsigned*)(P.ws + WS_CTL) + CW_BAR, bst);
#define IN(k) (lo <= (k) && (k) < hi)
#define SEAM(k) do { if (IN(k) && IN((k) + 1)) xcd_barrier(bar); } while (0)
    Sink S{P.out, (bf16_t*)(P.ws + WS_Q), (bf16_t*)(P.ws + WS_K), (bf16_t*)(P.ws + WS_VT), (bf16_t*)(P.ws + WS_SZA), (bf16_t*)(P.ws + WS_U), (bf16_t*)(P.ws + WS_G)};
    unsigned* kmax = (unsigned*)(P.ws + WS_CTL) + CTL_KMAX;
    if (IN(0)) { phase0(P, lds); }
    SEAM(0);
    if (IN(1)) {
        __syncthreads();
        pg8::Gemm g{(const pg8::bf16_t*)(P.ws + WS_H), (const pg8::bf16_t*)(P.ws + WS_WIN), MG, 4096, DM}; pg8::StaticOrder O; O.init(MG, 4096, gridDim.x, (int)blockIdx.x);
        pg8::EpiIn E{S, kmax};
        pg8::gemm_phase<pg8::EpiIn, pg8::StaticOrder, true, true>(lds, g, O, E);
        mini_inproj(P, S, kmax, lds);
        __syncthreads();
        scans(P, lds);
    }
    SEAM(1);
    if (IN(2)) { phase2(P, lds, bar); }
    SEAM(2);
    const bool fusedn = (gridDim.x == 256);
    if (IN(3)) {
        __syncthreads();
        pg8::Gemm g{(const pg8::bf16_t*)(P.ws + WS_A2), (const pg8::bf16_t*)(P.ws + WS_WOUT), MG, DM, DM}; pg8::StaticOrder O; O.init(MG, DM, gridDim.x, (int)blockIdx.x);
        if (fusedn) {
            pg8::EpiOutNorm E{P.x_prompt, P.out + O_YP, P.final_g, (unsigned*)(P.ws + WS_SSQ), (unsigned*)(P.ws + WS_CTL) + CW_SEAM, &P};
            pg8::gemm_phase<pg8::EpiOutNorm, pg8::StaticOrder, false, true>(lds, g, O, E);
            mini_out_finish(P, lds);
        } else {
            pg8::EpiOut E{P.x_prompt, P.out + O_YP, (float*)(P.ws + WS_SSQ)};
            pg8::gemm_phase<pg8::EpiOut, pg8::StaticOrder, true, true>(lds, g, O, E);
            mini_outproj(P);
        }
    }
    if (!fusedn) {
        SEAM(3);
        if (IN(4)) { phase4(P); }
    }
#undef IN
#undef SEAM
}

extern "C" void kernel_launch(void* const* d_in, const int* in_sizes, int n_in, void* d_out, int out_size, void* d_ws, size_t ws_size, hipStream_t stream) {
    static int grid = 0;
    if (grid == 0) {
        if (n_in != 13 || out_size != 34263296 || ws_size < WS_END) { fprintf(stderr, "kernel_launch: unexpected problem shape (n_in %d, out %d, ws %zu)\n", n_in, out_size, ws_size); grid = -1; return; }
        int dev = 0, cus = 0, per_cu = 0;
        hipGetDevice(&dev); hipDeviceGetAttribute(&cus, hipDeviceAttributeMultiprocessorCount, dev);
        hipFuncSetAttribute((const void*)hymba_fwd, hipFuncAttributeMaxDynamicSharedMemorySize, LDS_BYTES);
        hipOccupancyMaxActiveBlocksPerMultiprocessor(&per_cu, (const void*)hymba_fwd, 512, LDS_BYTES);
        if (per_cu < 1) { fprintf(stderr, "kernel_launch: occupancy query reports %d blocks per CU\n", per_cu); per_cu = 1; }
        grid = cus * 1;
        if (grid > 256) grid = 256;
    }
    if (grid < 0) return;
    if (hipMemsetAsync(d_ws, 0, CTL_ZERO_BYTES, stream) != hipSuccess) { fprintf(stderr, "kernel_launch: memset failed\n"); return; }
    Params p{};
    p.x_prompt = (const float*)d_in[0]; p.x_sample = (const float*)d_in[1]; p.cache_k = (const float*)d_in[2]; p.cache_v = (const float*)d_in[3]; p.cache_logf = (const float*)d_in[4];
    p.state_conv = (const float*)d_in[5]; p.meta = (const float*)d_in[6]; p.norm_g = (const float*)d_in[7]; p.w_in = (const float*)d_in[8]; p.b_f = (const float*)d_in[9];
    p.conv_w = (const float*)d_in[10]; p.w_out = (const float*)d_in[11]; p.final_g = (const float*)d_in[12];
    p.out = (float*)d_out; p.ws = (unsigned char*)d_ws;
#if MK_N_LAUNCHES == 1
    p.ph_lo = 0; p.ph_hi = 5;
    void* args[] = {&p};
    hipError_t e = hipLaunchCooperativeKernel((const void*)hymba_fwd, dim3(grid), dim3(512), args, LDS_BYTES, stream);
    if (e != hipSuccess) fprintf(stderr, "cooperative launch failed: %s (grid %d)\n", hipGetErrorString(e), grid);
#else
    for (int ph = 0; ph < 5; ++ph) { p.ph_lo = ph; p.ph_hi = ph + 1; hipLaunchKernelGGL(hymba_fwd, dim3(grid), dim3(512), LDS_BYTES, stream, p); }
#endif
}
```
